# Optimizing an MI355X kernel written in HIP

```python
import math, functools
import jax, jax.numpy as jnp
from jax import lax
import numpy as np

D_MODEL = 1024
BATCH = 4
SEQ = 4096
DEPTH = 1

CTX_LEN = 256
GRID_W = 64
D_MIX = D_MODEL
MLSTM_HEADS = 4
MLSTM_HEAD_DIM = D_MODEL // 8
D_MLSTM = MLSTM_HEADS * MLSTM_HEAD_DIM
FOURIER_GROUPS = 8
FOURIER_GROUP_DIM = (D_MIX - D_MLSTM) // FOURIER_GROUPS
D_FOURIER = FOURIER_GROUPS * FOURIER_GROUP_DIM
N_DIRS = 2
N_GATE_COLS = N_DIRS * 2 * MLSTM_HEADS
D_IN_PROJ = 4 * D_MLSTM + N_GATE_COLS + D_FOURIER
SPLITS = (2 * D_MLSTM, 3 * D_MLSTM, 4 * D_MLSTM, 4 * D_MLSTM + N_GATE_COLS)
CHUNK = 128
CONV_K = 3
N_EXPERTS = 64
TOP_K = 8
D_EXPERT = D_MODEL // 4
ROUTED_SCALE = 2.5
EXPERT_BLOCK = 128
DEEPNORM_ALPHA = (2.0 * DEPTH) ** 0.25
DEEPNORM_BETA = (8.0 * DEPTH) ** -0.25
LN_EPS = 1e-5

kernel_name = "hybrid_mlstm_fourier_moe_diffusion_block"


def layer_norm(x):
    xf = x.astype(jnp.float32)
    mu = xf.mean(-1, keepdims=True)
    var = jnp.mean(jnp.square(xf - mu), -1, keepdims=True)
    return ((xf - mu) * lax.rsqrt(var + LN_EPS)).astype(x.dtype)


def layer_norm_affine(x, gain, bias):
    return (layer_norm(x) * gain + bias).astype(x.dtype)


def modulate(u, shift, scale):
    return u * (1.0 + scale) + shift


def conv_grid(u, w, b, rows):
    bsz, n, ch = u.shape
    img = u.reshape(bsz, rows, GRID_W, ch)
    out = lax.conv_general_dilated(img, w[:, :, None, :], window_strides=(1, 1), padding="SAME",
                                   dimension_numbers=("NHWC", "HWIO", "NHWC"), feature_group_count=ch)
    return out.reshape(bsz, n, ch) + b


def conv_seq(u, w, b):
    ch = u.shape[-1]
    out = lax.conv_general_dilated(u, w[CONV_K // 2][:, None, :], window_strides=(1,), padding="SAME",
                                   dimension_numbers=("NWC", "WIO", "NWC"), feature_group_count=ch)
    return out + b


def split_heads(u):
    bsz, n, _ = u.shape
    return u.astype(jnp.float32).reshape(bsz, n, MLSTM_HEADS, MLSTM_HEAD_DIM).transpose(0, 2, 1, 3)


def zero_states(bsz):
    c0 = jnp.zeros((bsz, MLSTM_HEADS, MLSTM_HEAD_DIM, MLSTM_HEAD_DIM), jnp.float32)
    n0 = jnp.zeros((bsz, MLSTM_HEADS, MLSTM_HEAD_DIM), jnp.float32)
    m0 = jnp.zeros((bsz, MLSTM_HEADS), jnp.float32)
    return ((c0, n0, m0), (c0, n0, m0))


def mlstm_chunkwise(q, k, v, log_i, log_f, state):
    bsz, nh, n, dh = q.shape
    nc = n // CHUNK

    def to_chunks(t):
        return jnp.moveaxis(t.reshape(bsz, nh, nc, CHUNK, *t.shape[3:]), 2, 0)

    tri = jnp.tril(jnp.ones((CHUNK, CHUNK), dtype=bool))

    def step(carry, inp):
        c_prev, n_prev, m_prev = carry
        qc, kc, vc, li, lf = inp
        b = jnp.cumsum(lf, axis=-1)
        log_d = jnp.where(tri, b[..., :, None] - b[..., None, :] + li[..., None, :], -jnp.inf)
        m_t = jnp.maximum(b + m_prev[..., None], log_d.max(-1))
        d = jnp.exp(log_d - m_t[..., None])
        inter = jnp.exp(b + m_prev[..., None] - m_t)
        s = jnp.einsum("bhtd,bhsd->bhts", qc, kc) * d
        num = jnp.einsum("bhts,bhsd->bhtd", s, vc) + inter[..., None] * jnp.einsum("bhvd,bhtd->bhtv", c_prev, qc)
        den = s.sum(-1) + inter * jnp.einsum("bhd,bhtd->bht", n_prev, qc)
        h = num / jnp.maximum(jnp.abs(den), jnp.exp(-m_t))[..., None]
        b_last = b[..., -1]
        log_w = b_last[..., None] - b + li
        m_new = jnp.maximum(b_last + m_prev, log_w.max(-1))
        w = jnp.exp(log_w - m_new[..., None])
        decay = jnp.exp(b_last + m_prev - m_new)
        c_new = decay[..., None, None] * c_prev + jnp.einsum("bhs,bhsv,bhsd->bhvd", w, vc, kc)
        n_new = decay[..., None] * n_prev + jnp.einsum("bhs,bhsd->bhd", w, kc)
        return (c_new, n_new, m_new), h

    state, h = lax.scan(step, state, (to_chunks(q), to_chunks(k), to_chunks(v), to_chunks(log_i), to_chunks(log_f)))
    return jnp.moveaxis(h, 0, 2).reshape(bsz, nh, n, dh), state


def mixer_heads(stream, shift, scale, w_in, conv_fn, conv_w, conv_b, gate_b, states):
    proj = modulate(layer_norm(stream), shift, scale) @ w_in
    qk_pre, v, o_pre, g, f_in = jnp.split(proj, SPLITS, axis=-1)
    qk = jax.nn.silu(conv_fn(qk_pre, conv_w, conv_b))
    q, k = jnp.split(qk, 2, axis=-1)
    q = split_heads(q)
    k = split_heads(k) * MLSTM_HEAD_DIM ** -0.5
    v = split_heads(v)
    bsz, n, _ = g.shape
    pre = (g.reshape(bsz, n, N_DIRS, 2, MLSTM_HEADS) + gate_b).astype(jnp.float32)
    pre = jnp.transpose(pre, (2, 3, 0, 4, 1))
    log_i = pre[:, 0]
    log_f = jax.nn.log_sigmoid(pre[:, 1])
    h_fwd, st_fwd = mlstm_chunkwise(q, k, v, log_i[0], log_f[0], states[0])
    rev = lambda t: jnp.flip(t, axis=2)
    h_bwd, st_bwd = mlstm_chunkwise(rev(q), rev(k), rev(v), rev(log_i[1]), rev(log_f[1]), states[1])
    return h_fwd + rev(h_bwd), o_pre, f_in, (st_fwd, st_bwd)


def mlstm_readout(h, o_pre, head_g):
    bsz, nh, n, dh = h.shape
    hn = jnp.transpose(layer_norm(h), (0, 2, 1, 3)).reshape(bsz, n, nh * dh)
    return (hn * head_g * jax.nn.sigmoid(o_pre.astype(jnp.float32))).astype(o_pre.dtype)


def fourier_mix(u):
    bsz, n, _ = u.shape
    grp = u.astype(jnp.float32).reshape(bsz, n, FOURIER_GROUPS, FOURIER_GROUP_DIM)
    spec = jnp.fft.fft2(grp, axes=(1, 3), norm="ortho")
    return jnp.real(spec).reshape(bsz, n, D_FOURIER).astype(u.dtype)


def mixer_residual(stream, h_m, o_pre, f_in, gate, head_g, w_out, ln_g, ln_b):
    mix = jnp.concatenate([mlstm_readout(h_m, o_pre, head_g), fourier_mix(f_in)], axis=-1) @ w_out
    return layer_norm_affine(DEEPNORM_ALPHA * stream + gate * mix, ln_g, ln_b)


def moe_ffn(h, w_router, router_bias, w_expert_gu, w_expert_down, w_shared_gu, w_shared_down):
    bsz, n, d = h.shape
    t = h.reshape(bsz * n, d)
    n_tok = t.shape[0]
    n_assign = n_tok * TOP_K
    scores = jax.nn.sigmoid((t @ w_router).astype(jnp.float32))
    _, idx = lax.top_k(scores + router_bias.astype(jnp.float32), TOP_K)
    sel = jnp.take_along_axis(scores, idx, axis=-1)
    gate_w = ROUTED_SCALE * sel / sel.sum(-1, keepdims=True)
    flat_e = idx.reshape(-1)
    order = jnp.argsort(flat_e)
    sorted_e = flat_e[order]
    sizes = jnp.bincount(flat_e, length=N_EXPERTS)
    padded = (sizes + EXPERT_BLOCK - 1) // EXPERT_BLOCK * EXPERT_BLOCK
    start = jnp.cumsum(sizes) - sizes
    pad_end = jnp.cumsum(padded)
    pad_start = pad_end - padded
    dest = pad_start[sorted_e] + jnp.arange(n_assign) - start[sorted_e]
    n_rows = (n_assign + EXPERT_BLOCK - 1) // EXPERT_BLOCK * EXPERT_BLOCK + N_EXPERTS * EXPERT_BLOCK
    n_blocks = n_rows // EXPERT_BLOCK
    row_tok = jnp.zeros((n_rows,), jnp.int32).at[dest].set((order // TOP_K).astype(jnp.int32))
    row_w = jnp.zeros((n_rows,), jnp.float32).at[dest].set(gate_w.reshape(-1)[order])
    block_e = jnp.minimum(jnp.searchsorted(pad_end, jnp.arange(n_blocks) * EXPERT_BLOCK, side="right"), N_EXPERTS - 1)
    xb = t[row_tok].reshape(n_blocks, EXPERT_BLOCK, d)

    def expert_block(args):
        xblk, e = args
        g, u = jnp.split(xblk @ w_expert_gu[e], 2, axis=-1)
        return (jax.nn.silu(g) * u) @ w_expert_down[e]

    yb = lax.map(expert_block, (xb, block_e)).reshape(n_rows, d)
    routed = jax.ops.segment_sum(yb * row_w[:, None].astype(yb.dtype), row_tok, num_segments=n_tok)
    sg, su = jnp.split(t @ w_shared_gu, 2, axis=-1)
    shared = (jax.nn.silu(sg) * su) @ w_shared_down
    return (routed + shared).reshape(bsz, n, d)


def channel_residual(stream, shift, scale, gate, w_router, router_bias, w_expert_gu, w_expert_down,
                     w_shared_gu, w_shared_down, ln_g, ln_b):
    y = moe_ffn(modulate(layer_norm(stream), shift, scale), w_router, router_bias,
                w_expert_gu, w_expert_down, w_shared_gu, w_shared_down)
    return layer_norm_affine(DEEPNORM_ALPHA * stream + gate * y, ln_g, ln_b)


def setup_inputs(seed: int = 0) -> dict:
    key = jax.random.key(seed)
    ks = jax.random.split(key, 24)

    def nrm(k, shape, scale):
        return scale * jax.random.normal(k, shape, jnp.float32)

    f_bias = jnp.linspace(3.0, 6.0, MLSTM_HEADS, dtype=jnp.float32)
    gate_b = jnp.stack([nrm(ks[9], (DEPTH, N_DIRS, MLSTM_HEADS), 0.1),
                        f_bias + nrm(ks[10], (DEPTH, N_DIRS, MLSTM_HEADS), 0.1)], axis=2)
    return {
        "x": nrm(ks[0], (BATCH, SEQ, D_MODEL), 1.0),
        "c": nrm(ks[1], (BATCH, D_MODEL), 1.0),
        "ctx": nrm(ks[2], (BATCH, CTX_LEN, D_MODEL), 1.0),
        "c_ctx": nrm(ks[3], (D_MODEL,), 1.0),
        "w_ada": nrm(ks[4], (DEPTH, D_MODEL, 6 * D_MODEL), 0.5 * D_MODEL ** -0.5),
        "b_ada": nrm(ks[5], (DEPTH, 6 * D_MODEL), 0.02),
        "w_in": nrm(ks[6], (DEPTH, D_MODEL, D_IN_PROJ), D_MODEL ** -0.5),
        "conv_w": nrm(ks[7], (DEPTH, CONV_K, CONV_K, 2 * D_MLSTM), 1.0 / CONV_K),
        "conv_b": nrm(ks[8], (DEPTH, 2 * D_MLSTM), 0.02),
        "gate_b": gate_b,
        "head_g": 1.0 + nrm(ks[11], (DEPTH, D_MLSTM), 0.02),
        "w_out": nrm(ks[12], (DEPTH, D_MIX, D_MODEL), DEEPNORM_BETA * D_MIX ** -0.5),
        "ln1_g": 1.0 + nrm(ks[13], (DEPTH, D_MODEL), 0.02),
        "ln1_b": nrm(ks[14], (DEPTH, D_MODEL), 0.02),
        "w_router": nrm(ks[15], (DEPTH, D_MODEL, N_EXPERTS), D_MODEL ** -0.5),
        "router_bias": nrm(ks[16], (DEPTH, N_EXPERTS), 0.01),
        "w_expert_gu": nrm(ks[17], (DEPTH, N_EXPERTS, D_MODEL, 2 * D_EXPERT), D_MODEL ** -0.5),
        "w_expert_down": nrm(ks[18], (DEPTH, N_EXPERTS, D_EXPERT, D_MODEL), DEEPNORM_BETA * D_EXPERT ** -0.5),
        "w_shared_gu": nrm(ks[19], (DEPTH, D_MODEL, 2 * D_EXPERT), D_MODEL ** -0.5),
        "w_shared_down": nrm(ks[20], (DEPTH, D_EXPERT, D_MODEL), DEEPNORM_BETA * D_EXPERT ** -0.5),
        "ln2_g": 1.0 + nrm(ks[21], (DEPTH, D_MODEL), 0.02),
        "ln2_b": nrm(ks[22], (DEPTH, D_MODEL), 0.02),
    }


def reference(x, c, ctx, c_ctx, w_ada, b_ada, w_in, conv_w, conv_b, gate_b, head_g, w_out, ln1_g, ln1_b,
              w_router, router_bias, w_expert_gu, w_expert_down, w_shared_gu, w_shared_down, ln2_g, ln2_b):
    rows = x.shape[1] // GRID_W
    latent_conv = functools.partial(conv_grid, rows=rows)
    for l in range(DEPTH):
        mod_x = [m[:, None, :] for m in jnp.split(jax.nn.silu(c) @ w_ada[l] + b_ada[l], 6, axis=-1)]
        mod_c = jnp.split(jax.nn.silu(c_ctx) @ w_ada[l] + b_ada[l], 6, axis=-1)
        h_c, o_c, f_c, ctx_states = mixer_heads(ctx, mod_c[0], mod_c[1], w_in[l], conv_seq, conv_w[l], conv_b[l],
                                                gate_b[l], zero_states(ctx.shape[0]))
        h_x, o_x, f_x, _ = mixer_heads(x, mod_x[0], mod_x[1], w_in[l], latent_conv, conv_w[l], conv_b[l],
                                       gate_b[l], ctx_states)
        x = mixer_residual(x, h_x, o_x, f_x, mod_x[2], head_g[l], w_out[l], ln1_g[l], ln1_b[l])
        x = channel_residual(x, mod_x[3], mod_x[4], mod_x[5], w_router[l], router_bias[l], w_expert_gu[l],
                             w_expert_down[l], w_shared_gu[l], w_shared_down[l], ln2_g[l], ln2_b[l])
        if l + 1 < DEPTH:
            ctx = mixer_residual(ctx, h_c, o_c, f_c, mod_c[2], head_g[l], w_out[l], ln1_g[l], ln1_b[l])
            ctx = channel_residual(ctx, mod_c[3], mod_c[4], mod_c[5], w_router[l], router_bias[l], w_expert_gu[l],
                                   w_expert_down[l], w_shared_gu[l], w_shared_down[l], ln2_g[l], ln2_b[l])
    return x
```

```cpp
#include <hip/hip_runtime.h>
#include <cstdio>
#include <cstdint>

#ifndef MK_N_LAUNCHES
#define MK_N_LAUNCHES 1
#endif

#define LAS __attribute__((address_space(3)))
#define DI __device__ __forceinline__
typedef unsigned short bf16;
typedef float f32x4 __attribute__((ext_vector_type(4)));
typedef float f32x2 __attribute__((ext_vector_type(2)));
typedef short bf16x8 __attribute__((ext_vector_type(8)));
typedef unsigned u32x4 __attribute__((ext_vector_type(4)));
typedef unsigned u32x2 __attribute__((ext_vector_type(2)));

constexpr int NB = 4, SEQ = 4096, DM = 1024, CTXL = 256;
constexpr int MX = NB * SEQ;
constexpr int MC = NB * CTXL;
constexpr int MALL = MX + MC;
constexpr int NH = 4, HD = 128;
constexpr int DINP = 2576;
constexpr int NE = 64, TOPK = 8, DE = 256;
constexpr int NCH = 34;
constexpr int NITEM4 = 32 * NCH;
constexpr float LN_EPS = 1e-5f;
constexpr float ALPHA = 1.189207115002721f;
constexpr int MAXTILES = 640;

constexpr size_t MiB = 1u << 20;
constexpr size_t WS_CTL = 0, CTL_ZERO_BYTES = 1 * MiB;
constexpr size_t WS_MODP = 446 * MiB;
constexpr size_t WS_TAB = 2 * MiB;
constexpr size_t WS_GL = 3 * MiB;
constexpr size_t WS_ROWTAB = 5 * MiB;
constexpr size_t WS_EIDX = 9 * MiB;
constexpr size_t WS_EPOS = 9 * MiB + 512 * 1024;
constexpr size_t WS_EGATE = 10 * MiB;
constexpr size_t WS_SC = 11 * MiB;
constexpr size_t WS_NHAT = 11 * MiB + 64 * 1024;
constexpr size_t WS_NIN = 12 * MiB;
constexpr size_t WS_MIN = 12 * MiB + 512 * 1024;
constexpr size_t WS_WDT = 13 * MiB;
constexpr size_t WS_HB = 46 * MiB;
constexpr size_t WS_YB = 126 * MiB;
constexpr size_t WS_WGUT = 126 * MiB;
constexpr size_t WS_T = 191 * MiB;
constexpr size_t WS_WINT = 223 * MiB;
constexpr size_t WS_WOUTT = 229 * MiB;
constexpr size_t WS_XN = 231 * MiB;
constexpr size_t WS_MIXIN = 231 * MiB;
constexpr size_t WS_PROJ = 265 * MiB;
constexpr size_t WS_FCS = 333 * MiB;
constexpr size_t WS_QK = 365 * MiB;
constexpr size_t WS_CHAT = 399 * MiB;
constexpr size_t WS_CIN = 467 * MiB;
constexpr size_t WS_X1 = 446 * MiB;
constexpr size_t WS_MIXB = 265 * MiB;
constexpr size_t WS_END = 512 * MiB;
static_assert(WS_YB + (size_t)MAXTILES * 256 * 1024 * 2 <= WS_END, "YB");
static_assert(WS_CIN + (size_t)32 * 32 * 16384 * 2 <= WS_END, "CIN");
constexpr int CW_TMO = 0;
constexpr int CW_BAR = 4096;
constexpr int CW_CNT = 16384;
constexpr int CW_CNT2 = 24576;
constexpr int CW_MODDONE = 28672;
constexpr int CW_ADA = 20480;
constexpr int LDS_BYTES = 147456;
constexpr int LDS_ROWL = 131072;
constexpr int MOE1_SLOTS = 14;
constexpr int LDS_TB = 145408;
constexpr int LDS_MISC = 146432;

DI unsigned pk2(float lo, float hi) { unsigned r; asm("v_cvt_pk_bf16_f32 %0, %1, %2" : "=v"(r) : "v"(lo), "v"(hi)); return r; }
DI unsigned f2bf(float f) { return pk2(f, 0.f) & 0xffffu; }
typedef _Float16 f16x8 __attribute__((ext_vector_type(8)));
typedef _Float16 f16x2 __attribute__((ext_vector_type(2)));
DI unsigned pkh2(float lo, float hi) { const f16x2 h = (f16x2){(_Float16)lo, (_Float16)hi}; return __builtin_bit_cast(unsigned, h); }
DI float bf2f(unsigned b) { return __builtin_bit_cast(float, b << 16); }
DI float bflo(unsigned w) { return __builtin_bit_cast(float, w << 16); }
DI float bfhi(unsigned w) { return __builtin_bit_cast(float, w & 0xffff0000u); }
#define DPPF(x, ctrl) __builtin_bit_cast(float, __builtin_amdgcn_update_dpp(0, __builtin_bit_cast(int, (x)), (ctrl), 0xf, 0xf, false))
DI float red16(float v) { v += DPPF(v, 0xB1); v += DPPF(v, 0x4E); v += DPPF(v, 0x141); v += DPPF(v, 0x140); return v; }
DI float max16(float v) { v = fmaxf(v, DPPF(v, 0xB1)); v = fmaxf(v, DPPF(v, 0x4E)); v = fmaxf(v, DPPF(v, 0x141)); v = fmaxf(v, DPPF(v, 0x140)); return v; }
DI float rdl(float v, int l) { return __builtin_bit_cast(float, __builtin_amdgcn_readlane(__builtin_bit_cast(int, v), l)); }
DI float wave_sum(float v) { v = red16(v); return (rdl(v, 0) + rdl(v, 16)) + (rdl(v, 32) + rdl(v, 48)); }
DI float wave_max(float v) { v = max16(v); return fmaxf(fmaxf(rdl(v, 0), rdl(v, 16)), fmaxf(rdl(v, 32), rdl(v, 48))); }
DI int wave_min_i(int v) {
#pragma unroll
    for (int o = 1; o < 64; o <<= 1) { const int t = __shfl_xor(v, o); v = t < v ? t : v; }
    return v;
}
DI float scan_add(float x, int lane) {
#pragma unroll
    for (int o = 1; o < 64; o <<= 1) { const float t = __shfl_up(x, o); if (lane >= o) x += t; }
    return x;
}
DI float scan_max(float x, int lane) {
#pragma unroll
    for (int o = 1; o < 64; o <<= 1) { const float t = __shfl_up(x, o); if (lane >= o) x = fmaxf(x, t); }
    return x;
}
DI float siluf(float v) { return v * __builtin_amdgcn_rcpf(1.0f + __expf(-v)); }
DI float sigmf(float v) { return __builtin_amdgcn_rcpf(1.0f + __expf(-v)); }
DI float logsigf(float x) { return x >= 0.f ? -log1pf(expf(-x)) : x - log1pf(expf(x)); }
#define LDS_WAIT() asm volatile("s_waitcnt lgkmcnt(0)" ::: "memory")
#define VM_WAIT() asm volatile("s_waitcnt vmcnt(0)" ::: "memory")
#define MFMA16(a, b, c) __builtin_amdgcn_mfma_f32_16x16x32_bf16((a), (b), (c), 0, 0, 0)

DI unsigned lds_addr(const LAS void* p) { return (unsigned)(size_t)p; }
template <int ST, int KG> DI unsigned tr_base(unsigned tile, int lane) { return tile + (unsigned)((KG * (lane >> 4) + ((lane & 15) >> 2)) * ST + 8 * (lane & 3)); }
template <int O0, int O1> DI bf16x8 tr2(unsigned a) { u32x2 lo, hi;
    asm volatile("ds_read_b64_tr_b16 %0, %2 offset:%3\n\tds_read_b64_tr_b16 %1, %2 offset:%4\n\ts_waitcnt lgkmcnt(0)" : "=&v"(lo), "=&v"(hi) : "v"(a), "n"(O0), "n"(O1) : "memory");
    u32x4 r; r.x = lo.x; r.y = lo.y; r.z = hi.x; r.w = hi.y; return __builtin_bit_cast(bf16x8, r); }
template <int OB, int D2> DI void tr2x8(unsigned a, bf16x8 (&f)[8]) { u32x2 l0, l1, l2, l3, l4, l5, l6, l7, h0, h1, h2, h3, h4, h5, h6, h7;
    asm volatile("ds_read_b64_tr_b16 %0, %16 offset:%17\n\tds_read_b64_tr_b16 %1, %16 offset:%18\n\tds_read_b64_tr_b16 %2, %16 offset:%19\n\tds_read_b64_tr_b16 %3, %16 offset:%20\n\t"
                 "ds_read_b64_tr_b16 %4, %16 offset:%21\n\tds_read_b64_tr_b16 %5, %16 offset:%22\n\tds_read_b64_tr_b16 %6, %16 offset:%23\n\tds_read_b64_tr_b16 %7, %16 offset:%24\n\t"
                 "ds_read_b64_tr_b16 %8, %16 offset:%25\n\tds_read_b64_tr_b16 %9, %16 offset:%26\n\tds_read_b64_tr_b16 %10, %16 offset:%27\n\tds_read_b64_tr_b16 %11, %16 offset:%28\n\t"
                 "ds_read_b64_tr_b16 %12, %16 offset:%29\n\tds_read_b64_tr_b16 %13, %16 offset:%30\n\tds_read_b64_tr_b16 %14, %16 offset:%31\n\tds_read_b64_tr_b16 %15, %16 offset:%32\n\ts_waitcnt lgkmcnt(0)"
                 : "=&v"(l0), "=&v"(l1), "=&v"(l2), "=&v"(l3), "=&v"(l4), "=&v"(l5), "=&v"(l6), "=&v"(l7), "=&v"(h0), "=&v"(h1), "=&v"(h2), "=&v"(h3), "=&v"(h4), "=&v"(h5), "=&v"(h6), "=&v"(h7)
                 : "v"(a), "n"(OB), "n"(OB + 32), "n"(OB + 64), "n"(OB + 96), "n"(OB + 128), "n"(OB + 160), "n"(OB + 192), "n"(OB + 224),
                   "n"(OB + D2), "n"(OB + D2 + 32), "n"(OB + D2 + 64), "n"(OB + D2 + 96), "n"(OB + D2 + 128), "n"(OB + D2 + 160), "n"(OB + D2 + 192), "n"(OB + D2 + 224) : "memory");
#define TRP_(i, L, H) { u32x4 r; r.x = L.x; r.y = L.y; r.z = H.x; r.w = H.y; f[i] = __builtin_bit_cast(bf16x8, r); }
    TRP_(0, l0, h0) TRP_(1, l1, h1) TRP_(2, l2, h2) TRP_(3, l3, h3) TRP_(4, l4, h4) TRP_(5, l5, h5) TRP_(6, l6, h6) TRP_(7, l7, h7)
#undef TRP_
}

template <int OB, int D2> DI void tr2x4(unsigned a, bf16x8 (&f)[4]) { u32x2 l0, l1, l2, l3, h0, h1, h2, h3;
    asm volatile("ds_read_b64_tr_b16 %0, %8 offset:%9\n\tds_read_b64_tr_b16 %1, %8 offset:%10\n\tds_read_b64_tr_b16 %2, %8 offset:%11\n\tds_read_b64_tr_b16 %3, %8 offset:%12\n\t"
                 "ds_read_b64_tr_b16 %4, %8 offset:%13\n\tds_read_b64_tr_b16 %5, %8 offset:%14\n\tds_read_b64_tr_b16 %6, %8 offset:%15\n\tds_read_b64_tr_b16 %7, %8 offset:%16\n\ts_waitcnt lgkmcnt(0)"
                 : "=&v"(l0), "=&v"(l1), "=&v"(l2), "=&v"(l3), "=&v"(h0), "=&v"(h1), "=&v"(h2), "=&v"(h3)
                 : "v"(a), "n"(OB), "n"(OB + 32), "n"(OB + 64), "n"(OB + 96), "n"(OB + D2), "n"(OB + D2 + 32), "n"(OB + D2 + 64), "n"(OB + D2 + 96) : "memory");
#define TRP_(i, L, H) { u32x4 r; r.x = L.x; r.y = L.y; r.z = H.x; r.w = H.y; f[i] = __builtin_bit_cast(bf16x8, r); }
    TRP_(0, l0, h0) TRP_(1, l1, h1) TRP_(2, l2, h2) TRP_(3, l3, h3)
#undef TRP_
}

#define XB_TMO      128
#define XB_XCNT(j)  (256  + 64 * (j))
#define XB_XSUB(j)  (1280 + 64 * (j))
#define XB_XGEN(j)  (2304 + 64 * (j))
#define XB_TOP      3328
#define XB_TOPGEN   3392
#define XCD_BAR_WORDS 3456
#define XB_SPIN_CAP (1u << 18)
DI unsigned xb_ld(unsigned* p)              { return __hip_atomic_load(p, __ATOMIC_RELAXED, __HIP_MEMORY_SCOPE_AGENT); }
DI unsigned xb_add(unsigned* p, unsigned v) { return __hip_atomic_fetch_add(p, v, __ATOMIC_RELAXED, __HIP_MEMORY_SCOPE_AGENT); }
DI unsigned xb_xcc_id() { return (unsigned)__builtin_amdgcn_s_getreg((3 << 11) | 20) & 0xFu; }
#define XB_SPIN(cond, bar) do { unsigned _sp = 0; while (cond) { __builtin_amdgcn_s_sleep(1); \
    if ((++_sp & 255u) == 0u) { if (xb_ld(&(bar)[XB_TMO])) break; if (_sp > XB_SPIN_CAP) { atomicAdd(&(bar)[XB_TMO], 1u); break; } } } } while (0)
struct XcdBarrier { unsigned* bar; unsigned x; volatile LAS unsigned* st; };
DI XcdBarrier xcd_barrier_post(unsigned* bar, volatile LAS unsigned* st) {
    XcdBarrier b; b.bar = bar; b.x = xb_xcc_id(); b.st = st;
    if (threadIdx.x == 0) (void)xb_add(&bar[XB_XCNT(b.x)], 1u);
    return b;
}
DI void xcd_barrier_complete(unsigned* bar, unsigned x, unsigned& nloc, unsigned& nx) {
    const unsigned G = gridDim.x * gridDim.y * gridDim.z;
    unsigned sum, cnt, mine, sp = 0u;
    for (;;) {
        sum = 0u; cnt = 0u; mine = 0u;
#pragma unroll
        for (unsigned j = 0; j < 16; ++j) { const unsigned c = xb_ld(&bar[XB_XCNT(j)]); sum += c; cnt += (c > 0u) ? 1u : 0u; mine = (j == x) ? c : mine; }
        if (sum == G) break;
        __builtin_amdgcn_s_sleep(1);
        if ((++sp & 255u) == 0u) { if (xb_ld(&bar[XB_TMO])) break; if (sp > XB_SPIN_CAP) { atomicAdd(&bar[XB_TMO], 1u); break; } }
    }
    nloc = mine > 0u ? mine : 1u; nx = cnt > 0u ? cnt : 1u;
}
DI void xcd_barrier(const XcdBarrier& b) {
    asm volatile("s_waitcnt vmcnt(0)" ::: "memory");
    __syncthreads();
    if (threadIdx.x == 0) {
        unsigned* bar = b.bar;
        __builtin_amdgcn_s_waitcnt(0);
        unsigned nloc = b.st[0], nx = b.st[1];
        if (nloc == 0u) { xcd_barrier_complete(bar, b.x, nloc, nx); b.st[0] = nloc; b.st[1] = nx; }
        const unsigned old = xb_add(&bar[XB_XSUB(b.x)], 1u);
        const unsigned gen = old / nloc;
        if (old + 1u == (gen + 1u) * nloc) {
            __builtin_amdgcn_fence(__ATOMIC_RELEASE, "agent");
            asm volatile("s_waitcnt vmcnt(0)" ::: "memory");
            const unsigned og = xb_add(&bar[XB_TOP], 1u);
            const unsigned tg = og / nx;
            if (og + 1u == (tg + 1u) * nx) xb_add(&bar[XB_TOPGEN], 1u);
            else XB_SPIN(xb_ld(&bar[XB_TOPGEN]) == tg, bar);
            __builtin_amdgcn_fence(__ATOMIC_ACQUIRE, "agent");
            xb_add(&bar[XB_XGEN(b.x)], 1u);
            asm volatile("s_waitcnt vmcnt(0)" ::: "memory");
        } else {
            XB_SPIN(xb_ld(&bar[XB_XGEN(b.x)]) == gen, bar);
            __builtin_amdgcn_fence(__ATOMIC_ACQUIRE, "agent");
            asm volatile("s_waitcnt vmcnt(0)" ::: "memory");
        }
    }
    __syncthreads();
}

namespace pg8 {
constexpr int BM = 256, BK = 64, HALF = 128, HTB = HALF * BK * 2, STAGE_BYTES = 8 * HTB, NXCD = 8, WGM = 8;
__host__ __device__ __forceinline__ int lds_byte(int r, int c) { const int st = (r >> 4) * 2 + (c >> 5), rr = r & 15, cc = c & 31, ob = rr * 64 + cc * 2; return st * 1024 + (ob ^ (((ob >> 9) & 1) << 5)); }
__host__ __device__ __forceinline__ void stage_rc(int b, int& R, int& C) { const int st = b / 1024, sb = b % 1024, swz = sb ^ (((sb >> 9) & 1) << 5); R = (st >> 1) * 16 + swz / 64; C = (st & 1) * 32 + (swz % 64) / 2; }
__host__ __device__ __forceinline__ int perm32(int rho) { const int n = rho >> 4, i = rho & 15; return 8 * (i >> 2) + 4 * n + (i & 3); }
DI unsigned cvt_pk_bf16(float lo, float hi) { unsigned r; asm volatile("v_cvt_pk_bf16_f32 %0, %1, %2" : "=v"(r) : "v"(lo), "v"(hi)); return r; }
DI void static_tile(int L, int nM, int nN, int& pm, int& pn) {
    const int nwg = nM * nN; int wgid = L;
    { const int q = nwg / NXCD, r = nwg % NXCD, xcd = wgid % NXCD, off = wgid / NXCD; wgid = (xcd < r ? xcd * (q + 1) : r * (q + 1) + (xcd - r) * q) + off; }
    const int nig = WGM * nN, gid = wgid / nig, fm = gid * WGM, gsz = (nM - fm) < WGM ? (nM - fm) : WGM;
    pm = fm + ((wgid % nig) % gsz); pn = (wgid % nig) / gsz;
}
template <class Epi, class Sched>
DI void gemm_phase(LAS unsigned char* lds, const char* Abase, const int K, const Sched& S, const Epi& E) {
    const int tid = threadIdx.x, wid = __builtin_amdgcn_readfirstlane(tid >> 6), lane = tid & 63, wr = wid >> 2, wc = wid & 3, fr = lane & 15, fq = lane >> 4;
    const int nt = K / BK;
    unsigned voffB[2]; int Rr[2], Cc[2];
#pragma unroll
    for (int i = 0; i < 2; ++i) { int R, C; stage_rc(tid * 16 + i * 8192, R, C); Rr[i] = R; Cc[i] = C; const int Rb = Epi::PERM ? ((R & ~31) + perm32(R & 31)) : R; voffB[i] = (unsigned)(Rb * K + C) * 2u; }
    const size_t kstep = (size_t)(BK * 2);
    const size_t hstep = (size_t)HALF * K * 2;
    const unsigned ldsw = (unsigned)wid * 1024u;
    const int aoff = lds_byte(wr * 64 + fr, fq * 8), boff = lds_byte(wc * 32 + fr, fq * 8);
#define PG8_SA(b, h) (((b) * 2 + (h)) * HTB)
#define PG8_SB(b, h) ((4 + (b) * 2 + (h)) * HTB)
#define PG8_STAGE(bufoff, gbase, voff) do { _Pragma("unroll") for (int _i = 0; _i < 2; ++_i) \
        __builtin_amdgcn_global_load_lds((const unsigned*)((const char*)(gbase) + (voff)[_i]), (LAS unsigned*)(lds + (bufoff) + ldsw + _i * 8192), 16, 0, 0); } while (0)
#define PG8_LDA(dst, b, h) do { _Pragma("unroll") for (int m = 0; m < 4; ++m) _Pragma("unroll") for (int k = 0; k < 2; ++k) dst[m][k] = *(const LAS bf16x8*)(lds + PG8_SA(b, h) + aoff + m * 2048 + k * 1024); } while (0)
#define PG8_LDB(dst, b, h) do { _Pragma("unroll") for (int n = 0; n < 2; ++n) _Pragma("unroll") for (int k = 0; k < 2; ++k) dst[n][k] = *(const LAS bf16x8*)(lds + PG8_SB(b, h) + boff + n * 2048 + k * 1024); } while (0)
#define PG8_MMA(ai, bj, At, Bt) do { __builtin_amdgcn_s_setprio(1); _Pragma("unroll") for (int m = 0; m < 4; ++m) _Pragma("unroll") for (int n = 0; n < 2; ++n) _Pragma("unroll") for (int k = 0; k < 2; ++k) \
        acc[ai][bj][m][n] = __builtin_amdgcn_mfma_f32_16x16x32_bf16(Bt[n][k], At[m][k], acc[ai][bj][m][n], 0, 0, 0); __builtin_amdgcn_s_setprio(0); } while (0)
#define PG8_WAIT_V(n) asm volatile("s_waitcnt vmcnt(" #n ")" ::: "memory")
#define PG8_WAIT_L(n) asm volatile("s_waitcnt lgkmcnt(" #n ")" ::: "memory")
#define PG8_BAR __builtin_amdgcn_s_barrier()
#define PG8_SCHED __builtin_amdgcn_sched_barrier(0)
    typename Sched::Unit cur, nxt; int ui = 0;
    if (!S.next(0, cur)) return;
    f32x4 acc[2][2][4][2];
#pragma unroll
    for (int a = 0; a < 2; ++a)
#pragma unroll
        for (int b = 0; b < 2; ++b)
#pragma unroll
            for (int m = 0; m < 4; ++m)
#pragma unroll
                for (int n = 0; n < 2; ++n) acc[a][b][m][n] = (f32x4){0.f, 0.f, 0.f, 0.f};
    bf16x8 At[4][2], B0[2][2], B1[2][2];
    unsigned cAo[2][2], nAo[2][2];
    S.a_off(cur, Rr, Cc, cAo);
    const char* cB = S.b_ptr(cur);
    PG8_STAGE(PG8_SB(0, 0), cB, voffB); PG8_STAGE(PG8_SA(0, 0), Abase, cAo[0]); PG8_STAGE(PG8_SB(0, 1), cB + hstep, voffB); PG8_STAGE(PG8_SA(0, 1), Abase, cAo[1]);
    if (wr == 1) PG8_BAR;
    PG8_WAIT_V(4); PG8_BAR;
    PG8_STAGE(PG8_SB(1, 0), cB + kstep, voffB); PG8_STAGE(PG8_SA(1, 0), Abase + kstep, cAo[0]); PG8_STAGE(PG8_SB(1, 1), cB + hstep + kstep, voffB);
    PG8_WAIT_V(6); PG8_BAR;
    for (;;) {
        const bool has_next = S.next(ui + 1, nxt);
        const char* nB = cB;
#pragma unroll
        for (int h = 0; h < 2; ++h)
#pragma unroll
            for (int i = 0; i < 2; ++i) nAo[h][i] = cAo[h][i];
        if (has_next) { S.a_off(nxt, Rr, Cc, nAo); nB = S.b_ptr(nxt); }
        for (int t = 0; t < nt; t += 2) {
            const bool last = (t == nt - 2);
            const char* a1 = Abase + (size_t)(t + 1) * kstep;
            const char* a2 = last ? Abase : Abase + (size_t)(t + 2) * kstep; const char* b2 = last ? nB : cB + (size_t)(t + 2) * kstep;
            const char* a3 = a2 + kstep; const char* b3 = b2 + kstep;
            unsigned o2[2][2];
#pragma unroll
            for (int h = 0; h < 2; ++h)
#pragma unroll
                for (int i = 0; i < 2; ++i) o2[h][i] = last ? nAo[h][i] : cAo[h][i];
            PG8_LDB(B0, 0, 0); PG8_SCHED; PG8_LDA(At, 0, 0); PG8_STAGE(PG8_SA(1, 1), a1, cAo[1]);
            PG8_WAIT_L(8); PG8_BAR; PG8_WAIT_L(0); PG8_MMA(0, 0, At, B0); PG8_BAR; PG8_SCHED;
            PG8_LDB(B1, 0, 1); PG8_STAGE(PG8_SB(0, 0), b2, voffB);
            PG8_BAR; PG8_WAIT_L(0); PG8_MMA(0, 1, At, B1); PG8_BAR;
            PG8_LDA(At, 0, 1); PG8_STAGE(PG8_SA(0, 0), a2, o2[0]);
            PG8_BAR; PG8_WAIT_L(0); PG8_MMA(1, 0, At, B0); PG8_BAR; PG8_SCHED;
            PG8_STAGE(PG8_SB(0, 1), b2 + hstep, voffB);
            PG8_WAIT_V(6); PG8_BAR; PG8_MMA(1, 1, At, B1); PG8_BAR;
            PG8_LDB(B0, 1, 0); PG8_SCHED; PG8_LDA(At, 1, 0); PG8_STAGE(PG8_SA(0, 1), a2, o2[1]);
            PG8_WAIT_L(8); PG8_BAR; PG8_WAIT_L(0); PG8_MMA(0, 0, At, B0); PG8_BAR; PG8_SCHED;
            PG8_LDB(B1, 1, 1); PG8_STAGE(PG8_SB(1, 0), b3, voffB);
            PG8_BAR; PG8_WAIT_L(0); PG8_MMA(0, 1, At, B1); PG8_BAR;
            PG8_LDA(At, 1, 1); PG8_STAGE(PG8_SA(1, 0), a3, o2[0]);
            PG8_BAR; PG8_WAIT_L(0); PG8_MMA(1, 0, At, B0); PG8_BAR; PG8_SCHED;
            PG8_STAGE(PG8_SB(1, 1), b3 + hstep, voffB);
            PG8_WAIT_V(6); PG8_BAR; PG8_MMA(1, 1, At, B1); PG8_BAR;
        }
        E(acc, cur, wr, wc, fr, fq);
        if (!has_next) break;
#pragma unroll
        for (int a = 0; a < 2; ++a)
#pragma unroll
            for (int b = 0; b < 2; ++b)
#pragma unroll
                for (int m = 0; m < 4; ++m)
#pragma unroll
                    for (int n = 0; n < 2; ++n) acc[a][b][m][n] = (f32x4){0.f, 0.f, 0.f, 0.f};
        cur = nxt; cB = nB; ++ui;
#pragma unroll
        for (int h = 0; h < 2; ++h)
#pragma unroll
            for (int i = 0; i < 2; ++i) cAo[h][i] = nAo[h][i];
    }
    PG8_WAIT_V(0);
    if (wr == 0) PG8_BAR;
    PG8_BAR;
#undef PG8_SA
#undef PG8_SB
#undef PG8_STAGE
#undef PG8_LDA
#undef PG8_LDB
#undef PG8_MMA
#undef PG8_WAIT_V
#undef PG8_WAIT_L
#undef PG8_BAR
#undef PG8_SCHED
}
}

struct Args { const float* in[22]; float* out; unsigned char* ws; int ph_lo, ph_hi, li, pad; };
struct Ctx {
    LAS unsigned char* lds;
    int tid, lane, wave, G, bid, dry;
    const float *x, *c, *ctx, *c_ctx, *w_ada, *b_ada, *w_in, *conv_w, *conv_b, *gate_b, *head_g, *w_out, *ln1_g, *ln1_b, *w_router, *router_bias, *w_egu, *w_ed, *w_sgu, *w_sd, *ln2_g, *ln2_b;
    float* out; unsigned char* ws;
    DI float* MODP() const { return (float*)(ws + WS_MODP); }
    DI float* MOD() const { return (float*)(ws + WS_TAB + 131072); }
    DI bf16* W1() const { return (bf16*)(ws + WS_TAB); }
    DI bf16* W2() const { return (bf16*)(ws + WS_TAB + 32768); }
    DI bf16* W2I() const { return (bf16*)(ws + WS_TAB + 49152); }
    DI bf16* WRH() const { return (bf16*)(ws + WS_TAB + 262144); }
    DI bf16* WRL() const { return (bf16*)(ws + WS_TAB + 393216); }
    DI f32x2* TW() const { return (f32x2*)(ws + WS_TAB + 65536); }
    DI float* GL() const { return (float*)(ws + WS_GL); }
    DI int* ROWTAB() const { return (int*)(ws + WS_ROWTAB); }
    DI int* EIDX() const { return (int*)(ws + WS_EIDX); }
    DI int* EPOS() const { return (int*)(ws + WS_EPOS); }
    DI float* EGATE() const { return (float*)(ws + WS_EGATE); }
    DI float* SC() const { return (float*)(ws + WS_SC); }
    DI float* NHAT() const { return (float*)(ws + WS_NHAT); }
    DI float* NIN() const { return (float*)(ws + WS_NIN); }
    DI float* MINV() const { return (float*)(ws + WS_MIN); }
    DI bf16* WDT() const { return (bf16*)(ws + WS_WDT); }
    DI bf16* HB() const { return (bf16*)(ws + WS_HB); }
    DI bf16* YB() const { return (bf16*)(ws + WS_YB); }
    DI bf16* WGUT() const { return (bf16*)(ws + WS_WGUT); }
    DI bf16* T() const { return (bf16*)(ws + WS_T); }
    DI bf16* WINT() const { return (bf16*)(ws + WS_WINT); }
    DI bf16* WOUTT() const { return (bf16*)(ws + WS_WOUTT); }
    DI bf16* XN() const { return (bf16*)(ws + WS_XN); }
    DI bf16* MIXIN() const { return (bf16*)(ws + WS_MIXIN); }
    DI bf16* PROJ() const { return (bf16*)(ws + WS_PROJ); }
    DI bf16* FCS() const { return (bf16*)(ws + WS_FCS); }
    DI bf16* QK() const { return (bf16*)(ws + WS_QK); }
    DI bf16* CIN() const { return (bf16*)(ws + WS_CIN); }
    DI float* CHAT() const { return (float*)(ws + WS_CHAT); }
    DI bf16* X1() const { return (bf16*)(ws + WS_X1); }
    DI bf16* MIXB() const { return (bf16*)(ws + WS_MIXB); }
    DI unsigned* ctl() const { return (unsigned*)(ws + WS_CTL); }
};

DI void p0_router_item(const Ctx& F, int item, LAS float* scr) {
    const int kb = item >> 1, nb = item & 1, k0 = 64 * kb, lane = F.lane;
    float t[32];
#pragma unroll
    for (int i = 0; i < 32; ++i) t[i] = F.w_router[(size_t)(k0 + 2 * i + (lane >> 5)) * 64 + 32 * nb + (lane & 31)];
#pragma unroll
    for (int i = 0; i < 32; ++i) scr[(2 * i + (lane >> 5)) * 33 + (lane & 31)] = t[i];
    LDS_WAIT();
    const int c = lane & 7;
#pragma unroll
    for (int j = 0; j < 4; ++j) { const int n = (lane >> 3) + 8 * j; const LAS float* sp = scr + (8 * c) * 33 + n;
        u32x4 oh; oh.x = pkh2(sp[0 * 33], sp[1 * 33]); oh.y = pkh2(sp[2 * 33], sp[3 * 33]); oh.z = pkh2(sp[4 * 33], sp[5 * 33]); oh.w = pkh2(sp[6 * 33], sp[7 * 33]);
        *(u32x4*)(F.WRH() + (size_t)(32 * nb + n) * 1024 + k0 + 8 * c) = oh; }
    LDS_WAIT();
}
DI void p0_adaln_item(const Ctx& F, int item, LAS float* scr) {
    const int cg = item % 24, ks = item / 24, lane = F.lane, col = 256 * cg + 4 * lane;
    { const int k = 64 * ks + lane;
#pragma unroll
      for (int r = 0; r < 5; ++r) { const float v = r < 4 ? F.c[r * 1024 + k] : F.c_ctx[k]; scr[lane * 8 + r] = v / (1.0f + expf(-v)); } }
    LDS_WAIT();
    f32x4 acc[5];
#pragma unroll
    for (int r = 0; r < 5; ++r) acc[r] = (f32x4){0.f, 0.f, 0.f, 0.f};
    const float* wp = F.w_ada + (size_t)(64 * ks) * 6144 + col;
#pragma unroll 1
    for (int k0 = 0; k0 < 64; k0 += 32) {
        f32x4 wv[32];
#pragma unroll
        for (int i = 0; i < 32; ++i) wv[i] = __builtin_nontemporal_load((const f32x4*)(wp + (size_t)(k0 + i) * 6144));
#pragma unroll
        for (int i = 0; i < 32; ++i) { const f32x4 s0 = *(const LAS f32x4*)(scr + (k0 + i) * 8); const float s4 = scr[(k0 + i) * 8 + 4];
            acc[0] += wv[i] * s0.x; acc[1] += wv[i] * s0.y; acc[2] += wv[i] * s0.z; acc[3] += wv[i] * s0.w; acc[4] += wv[i] * s4; } }
#pragma unroll
    for (int r = 0; r < 5; ++r) { unsigned long long* p = (unsigned long long*)(F.MODP() + (size_t)(ks * 5 + r) * 6144 + col);
        const f32x2 lo2 = (f32x2){acc[r].x, acc[r].y}, hi2 = (f32x2){acc[r].z, acc[r].w};
        __hip_atomic_store(p, __builtin_bit_cast(unsigned long long, lo2), __ATOMIC_RELAXED, __HIP_MEMORY_SCOPE_AGENT);
        __hip_atomic_store(p + 1, __builtin_bit_cast(unsigned long long, hi2), __ATOMIC_RELAXED, __HIP_MEMORY_SCOPE_AGENT); }
    asm volatile("s_waitcnt vmcnt(0)" ::: "memory");
    unsigned old = 0u; if (lane == 0) old = __hip_atomic_fetch_add(F.ctl() + CW_ADA + 16 * cg, 1u, __ATOMIC_RELAXED, __HIP_MEMORY_SCOPE_AGENT);
    old = (unsigned)__builtin_amdgcn_readfirstlane((int)old);
    if (old == 15u) {
#pragma unroll 1
        for (int r = 0; r < 5; ++r) { unsigned long long pa[16], pb[16];
#pragma unroll
            for (int q = 0; q < 16; ++q) { const unsigned long long* p = (const unsigned long long*)(F.MODP() + (size_t)(q * 5 + r) * 6144 + col);
                pa[q] = __hip_atomic_load(p, __ATOMIC_RELAXED, __HIP_MEMORY_SCOPE_AGENT); pb[q] = __hip_atomic_load(p + 1, __ATOMIC_RELAXED, __HIP_MEMORY_SCOPE_AGENT); }
            f32x4 sum = *(const f32x4*)(F.b_ada + col);
#pragma unroll
            for (int q = 0; q < 16; ++q) { const f32x2 a = __builtin_bit_cast(f32x2, pa[q]), b = __builtin_bit_cast(f32x2, pb[q]); sum.x += a.x; sum.y += a.y; sum.z += b.x; sum.w += b.y; }
            unsigned long long* mp = (unsigned long long*)(F.MOD() + r * 6144 + col); const f32x2 lo2 = (f32x2){sum.x, sum.y}, hi2 = (f32x2){sum.z, sum.w};
            __hip_atomic_store(mp, __builtin_bit_cast(unsigned long long, lo2), __ATOMIC_RELAXED, __HIP_MEMORY_SCOPE_AGENT);
            __hip_atomic_store(mp + 1, __builtin_bit_cast(unsigned long long, hi2), __ATOMIC_RELAXED, __HIP_MEMORY_SCOPE_AGENT); }
        asm volatile("s_waitcnt vmcnt(0)" ::: "memory");
        if (lane == 0) __hip_atomic_fetch_add(F.ctl() + CW_MODDONE, 1u, __ATOMIC_RELAXED, __HIP_MEMORY_SCOPE_AGENT); }
    LDS_WAIT();
}
DI void p0_fold_item(const Ctx& F, int item, LAS float* scr) {
    const int g = item & 7, kb = item >> 3, lane = F.lane, k0 = 32 * kb;
    { float t[32];
#pragma unroll
      for (int i = 0; i < 32; ++i) t[i] = F.w_in[(size_t)(k0 + i) * DINP + 2064 + 64 * g + lane];
#pragma unroll
      for (int i = 0; i < 32; ++i) scr[i * 68 + lane] = t[i]; }
    LDS_WAIT();
    const bool isc = lane <= 32; const int jf = isc ? lane : lane - 32;
    float acc[32];
#pragma unroll
    for (int i = 0; i < 32; ++i) acc[i] = 0.f;
#pragma unroll 1
    for (int ch = 0; ch < 4; ++ch) {
        float tb[16];
#pragma unroll
        for (int c = 0; c < 16; ++c) { const float a = (float)((jf * (16 * ch + c)) & 63) * (1.0f / 64.0f); tb[c] = isc ? __builtin_amdgcn_cosf(a) : __builtin_amdgcn_sinf(a); }
#pragma unroll
        for (int i = 0; i < 32; ++i) {
#pragma unroll
            for (int c4 = 0; c4 < 4; ++c4) { const f32x4 xv = *(const LAS f32x4*)(scr + i * 68 + 16 * ch + 4 * c4);
                acc[i] += (xv.x * tb[4 * c4] + xv.y * tb[4 * c4 + 1]) + (xv.z * tb[4 * c4 + 2] + xv.w * tb[4 * c4 + 3]); }
            if ((i & 3) == 3) asm volatile("" ::: "memory"); }
    }
    bf16* dp = F.WINT() + (size_t)(2048 + 64 * g + lane) * 1024 + k0;
#pragma unroll
    for (int i8 = 0; i8 < 4; ++i8) { u32x4 o; o.x = pk2(acc[8 * i8], acc[8 * i8 + 1]); o.y = pk2(acc[8 * i8 + 2], acc[8 * i8 + 3]); o.z = pk2(acc[8 * i8 + 4], acc[8 * i8 + 5]); o.w = pk2(acc[8 * i8 + 6], acc[8 * i8 + 7]);
        *(u32x4*)(dp + 8 * i8) = o; }
    LDS_WAIT();
}
DI void p0_tables_item(const Ctx& F, int item) {
    const int idx = item * 64 + F.lane;
    if (idx < 16384) { const int m = idx >> 7, k = idx & 127, ri = m >> 6, k1 = m & 63, cs = k >> 6, n1 = k & 63;
        const float a = (float)((k1 * n1) & 63) * (1.0f / 64.0f), cv = __builtin_amdgcn_cosf(a), sv = __builtin_amdgcn_sinf(a);
        const float v = ri == 0 ? (cs == 0 ? cv : -sv) : (cs == 0 ? -sv : -cv); F.W1()[idx] = (bf16)f2bf(v); }
    else if (idx < 24576) { const int j = idx - 16384, k2 = j >> 7, k = j & 127, ri = k >> 6, n2 = k & 63;
        const float a = (float)((k2 * n2) & 63) * (1.0f / 64.0f), cv = __builtin_amdgcn_cosf(a), sv = __builtin_amdgcn_sinf(a);
        F.W2()[j] = (bf16)f2bf(ri == 0 ? cv : sv); F.W2I()[j] = (bf16)f2bf(ri == 0 ? -sv : cv); }
    else { const int j = idx - 24576; const float a = (float)j * (6.283185307179586f / 4096.0f); F.TW()[j] = (f32x2){cosf(a), sinf(a)}; }
}
struct TDesc { const float* src; bf16* dst; int ldw, K; };
constexpr int T_IN = 16 * 64, T_OUT = 16 * 32, T_GU = 65 * 256, T_DN = 65 * 128, T_ALL = T_IN + T_OUT + T_GU + T_DN;
constexpr int P2_BUSY = 664 - 512;
constexpr int T_LATE = (256 - P2_BUSY) * 8 * 10, T_EARLY = T_ALL - T_LATE;
DI void p0_tdesc(const Ctx& F, int r, int lane, TDesc& d) {
    const float* W; int ldw, col0, K, k0; bf16* dst;
    if (r < T_IN) { const int kb = r >> 6, nb = r & 63; W = F.w_in; ldw = DINP; col0 = 32 * nb; K = 1024; k0 = 64 * kb; dst = F.WINT() + (size_t)(32 * nb) * 1024; }
    else if (r < T_IN + T_OUT) { const int q = r - T_IN, kb = q >> 5, nb = q & 31; W = F.w_out; ldw = 1024; col0 = 32 * nb; K = 1024; k0 = 64 * kb; dst = F.WOUTT() + (size_t)(32 * nb) * 1024; }
    else if (r < T_IN + T_OUT + T_GU) { const int q0 = r - T_IN - T_OUT, e = q0 >> 8, q = q0 & 255, kb = q >> 4, nb = q & 15;
        W = e < 64 ? F.w_egu + (size_t)e * 1024 * 512 : F.w_sgu; ldw = 512; col0 = 32 * nb; K = 1024; k0 = 64 * kb;
        const int bj = col0 >> 8, hid = col0 & 255, drow = 256 * (hid >> 7) + 128 * bj + (hid & 127); dst = F.WGUT() + ((size_t)e * 512 + drow) * 1024; }
    else { const int q0 = r - T_IN - T_OUT - T_GU, e = q0 >> 7, q = q0 & 127, kb = q >> 5, nb = q & 31;
        W = e < 64 ? F.w_ed + (size_t)e * 256 * 1024 : F.w_sd; ldw = 1024; col0 = 32 * nb; K = 256; k0 = 64 * kb; dst = F.WDT() + ((size_t)e * 1024 + 32 * nb) * 256; }
    d.src = W + (size_t)(k0 + (lane >> 5)) * ldw + col0 + (lane & 31); d.dst = dst + k0; d.ldw = ldw; d.K = K;
}
DI void p0_tload(const TDesc& d, float (&t)[32]) {
#pragma unroll
    for (int i = 0; i < 32; ++i) t[i] = __builtin_nontemporal_load(d.src + (size_t)(2 * i) * d.ldw);
}
DI void p0_tstore(const TDesc& d, const float (&t)[32], LAS float* scr, int lane) {
#pragma unroll
    for (int i = 0; i < 32; ++i) scr[(2 * i + (lane >> 5)) * 33 + (lane & 31)] = t[i];
    LDS_WAIT();
    const int c = lane & 7;
#pragma unroll
    for (int j = 0; j < 4; ++j) { const int n = (lane >> 3) + 8 * j; const LAS float* s = scr + (8 * c) * 33 + n;
        u32x4 o; o.x = pk2(s[0 * 33], s[1 * 33]); o.y = pk2(s[2 * 33], s[3 * 33]); o.z = pk2(s[4 * 33], s[5 * 33]); o.w = pk2(s[6 * 33], s[7 * 33]);
        *(u32x4*)(d.dst + (size_t)n * d.K + 8 * c) = o; }
    LDS_WAIT();
}
DI void p0_transposes(const Ctx& F, LAS float* scr, int first, int stride, int end) {
    int it = first; TDesc dA, dB; float tA[32], tB[32];
    bool vA = it < end; if (vA) { p0_tdesc(F, it, F.lane, dA); p0_tload(dA, tA); }
    while (vA) {
        const int n1 = it + stride; const bool vB = n1 < end; if (vB) { p0_tdesc(F, n1, F.lane, dB); p0_tload(dB, tB); }
        p0_tstore(dA, tA, scr, F.lane);
        if (!vB) break;
        const int n2 = n1 + stride; vA = n2 < end; if (vA) { p0_tdesc(F, n2, F.lane, dA); p0_tload(dA, tA); }
        p0_tstore(dB, tB, scr, F.lane);
        it = n2;
    }
}
DI void p0_prologue(const Ctx& F) {
    LAS float* scr = (LAS float*)(F.lds + F.wave * 17408);
    const int gw = F.bid * 8 + F.wave, NGW = F.G * 8;
    constexpr int I_ADA = 384, I_FOLD = 256, I_TAB = 448, I_RT = 32, NSPEC = I_FOLD + I_ADA + I_TAB + I_RT;
    for (int it = gw; it < NSPEC; it += NGW) {
        int r = it;
        if (r < I_FOLD) { p0_fold_item(F, r, scr); continue; } r -= I_FOLD;
        if (r < I_ADA) { p0_adaln_item(F, r, scr); continue; } r -= I_ADA;
        if (r < I_TAB) { p0_tables_item(F, r); continue; } r -= I_TAB;
        p0_router_item(F, r, scr);
    }
    p0_transposes(F, scr, gw, NGW, (F.G == 256 && MK_N_LAUNCHES == 1) ? T_EARLY : T_ALL);
}

DI void p1_lnmod(const Ctx& F) {
    LAS float* modL = (LAS float*)F.lds;
    LAS bf16* tH = (LAS bf16*)(F.lds + 40960);
    LAS bf16* tLo = (LAS bf16*)(F.lds + 73984);
    LAS float* PL = (LAS float*)(F.lds + 107008);
    const int lane = F.lane, w = F.wave, tid = F.tid, fr = lane & 15, fq = lane >> 4;
    __syncthreads();
    bf16x8 wbh[4], wbl[4];
#pragma unroll
    for (int kk = 0; kk < 4; ++kk) { unsigned hi[8], lo[8];
#pragma unroll
        for (int j = 0; j < 8; ++j) { const float x = F.w_in[(size_t)(128 * w + 32 * kk + 8 * fq + j) * DINP + 2048 + fr]; hi[j] = f2bf(x); lo[j] = f2bf(x - bf2f(hi[j])); }
        u32x4 oh, ol; oh.x = hi[0] | (hi[1] << 16); oh.y = hi[2] | (hi[3] << 16); oh.z = hi[4] | (hi[5] << 16); oh.w = hi[6] | (hi[7] << 16);
        ol.x = lo[0] | (lo[1] << 16); ol.y = lo[2] | (lo[3] << 16); ol.z = lo[4] | (lo[5] << 16); ol.w = lo[6] | (lo[7] << 16);
        wbh[kk] = __builtin_bit_cast(bf16x8, oh); wbl[kk] = __builtin_bit_cast(bf16x8, ol); }
    if (MK_N_LAUNCHES == 1) {
        if (tid == 0) { unsigned sp = 0; while (__hip_atomic_load(F.ctl() + CW_MODDONE, __ATOMIC_RELAXED, __HIP_MEMORY_SCOPE_AGENT) < 24u && ++sp < (1u << 22)) __builtin_amdgcn_s_sleep(2); }
        __syncthreads(); }
    for (int i = tid; i < 5 * 2048; i += 512) modL[i] = __builtin_bit_cast(float, __hip_atomic_load((unsigned*)F.MOD() + (i >> 11) * 6144 + (i & 2047), __ATOMIC_RELAXED, __HIP_MEMORY_SCOPE_AGENT));
    __syncthreads();
    for (int g16 = F.bid; g16 < MALL / 16; g16 += F.G) {
        const int row0 = 16 * g16 + 2 * w;
        const int mr = row0 < MX ? (row0 >> 12) : 4;
        f32x4 xa[2][4];
#pragma unroll
        for (int rr = 0; rr < 2; ++rr) { const int row = row0 + rr; const float* xr = row < MX ? F.x + (size_t)row * 1024 : F.ctx + (size_t)(row - MX) * 1024;
#pragma unroll
            for (int m = 0; m < 4; ++m) xa[rr][m] = __builtin_nontemporal_load((const f32x4*)(xr + 256 * m + 4 * lane)); }
#pragma unroll
        for (int rr = 0; rr < 2; ++rr) {
            const int lr = 2 * w + rr, row = row0 + rr;
            f32x4 v[4]; float s = 0.f;
#pragma unroll
            for (int m = 0; m < 4; ++m) { v[m] = xa[rr][m]; s += (v[m].x + v[m].y) + (v[m].z + v[m].w); }
            const float mean = wave_sum(s) * (1.0f / 1024.0f); float s2 = 0.f;
#pragma unroll
            for (int m = 0; m < 4; ++m) { v[m] = v[m] - mean; s2 += (v[m].x * v[m].x + v[m].y * v[m].y) + (v[m].z * v[m].z + v[m].w * v[m].w); }
            const float rstd = 1.0f / sqrtf(wave_sum(s2) * (1.0f / 1024.0f) + LN_EPS);
            bf16* xo = F.XN() + (size_t)row * 1024;
#pragma unroll
            for (int m = 0; m < 4; ++m) { const int k = 256 * m + 4 * lane; const f32x4 sh = *(const LAS f32x4*)(modL + mr * 2048 + k), sc = *(const LAS f32x4*)(modL + mr * 2048 + 1024 + k);
                const f32x4 t = v[m] * rstd * (sc + 1.0f) + sh;
                u32x2 oh; oh.x = pk2(t.x, t.y); oh.y = pk2(t.z, t.w); *(u32x2*)(xo + k) = oh; *(LAS u32x2*)(tH + lr * 1032 + k) = oh;
                u32x2 ol; ol.x = pk2(t.x - bflo(oh.x), t.y - bfhi(oh.x)); ol.y = pk2(t.z - bflo(oh.y), t.w - bfhi(oh.y)); *(LAS u32x2*)(tLo + lr * 1032 + k) = ol; }
        }
        __syncthreads();
        {
            f32x4 a0 = (f32x4){0.f, 0.f, 0.f, 0.f}, a1 = a0, a2 = a0;
#pragma unroll
            for (int kk = 0; kk < 4; ++kk) { const bf16x8 ah = *(const LAS bf16x8*)(tH + fr * 1032 + 128 * w + 32 * kk + 8 * fq), al = *(const LAS bf16x8*)(tLo + fr * 1032 + 128 * w + 32 * kk + 8 * fq);
                a0 = MFMA16(ah, wbh[kk], a0); a1 = MFMA16(ah, wbl[kk], a1); a2 = MFMA16(al, wbh[kk], a2); }
#pragma unroll
            for (int r = 0; r < 4; ++r) PL[(w * 16 + 4 * fq + r) * 16 + fr] = a0[r] + (a1[r] + a2[r]);
        }
        __syncthreads();
        if (tid < 256) { const int lr = tid >> 4, g = tid & 15; float pre = F.gate_b[g];
#pragma unroll
            for (int ww = 0; ww < 8; ++ww) pre += PL[(ww * 16 + lr) * 16 + g];
            F.GL()[(size_t)(16 * g16 + lr) * 16 + g] = ((g >> 2) & 1) ? logsigf(pre) : pre; }
        __syncthreads();
    }
}

struct ProjOrder {
    struct Unit { int pm, pn; };
    int G, c; const bf16* WinT;
    DI bool next(int i, Unit& u) const { const int L = i * G + c; if (L >= 664) return false;
        if (L < 640) pg8::static_tile(L, 64, 10, u.pm, u.pn); else { const int j = L - 640; u.pm = 64 + j / 6; u.pn = j % 6; } return true; }
    DI void a_off(const Unit& u, const int (&R)[2], const int (&C)[2], unsigned (&off)[2][2]) const {
#pragma unroll
        for (int h = 0; h < 2; ++h)
#pragma unroll
            for (int i = 0; i < 2; ++i) off[h][i] = (unsigned)((u.pm * 256 + h * 128 + R[i]) * 1024 + C[i]) * 2u; }
    DI const char* b_ptr(const Unit& u) const { return (const char*)(WinT + (size_t)u.pn * 256 * 1024); }
};
struct EpiProj {
    static constexpr bool PERM = true;
    bf16* PROJ; bf16* FCS;
    DI void operator()(const f32x4 (&acc)[2][2][4][2], const ProjOrder::Unit& u, int wr, int wc, int fr, int fq) const {
        const int row0 = u.pm * 256 + wr * 64 + fr;
        if (u.pn < 8) {
            const int col0 = u.pn * 256 + wc * 32 + 8 * fq;
#pragma unroll
            for (int ai = 0; ai < 2; ++ai)
#pragma unroll
                for (int m = 0; m < 4; ++m) { bf16* rowp = PROJ + (size_t)(row0 + ai * 128 + m * 16) * 2048 + col0;
#pragma unroll
                    for (int bj = 0; bj < 2; ++bj) { const f32x4 v0 = acc[ai][bj][m][0], v1 = acc[ai][bj][m][1];
                        u32x4 w; w.x = pg8::cvt_pk_bf16(v0[0], v0[1]); w.y = pg8::cvt_pk_bf16(v0[2], v0[3]); w.z = pg8::cvt_pk_bf16(v1[0], v1[1]); w.w = pg8::cvt_pk_bf16(v1[2], v1[3]);
                        *(u32x4*)(rowp + bj * 128) = w; } }
        } else {
            const int sc0 = (u.pn - 8) * 256 + wc * 32 + 8 * fq;
#pragma unroll
            for (int ai = 0; ai < 2; ++ai)
#pragma unroll
                for (int m = 0; m < 4; ++m) { const int row = row0 + ai * 128 + m * 16, b = row >> 12, n = row & 4095;
#pragma unroll
                    for (int bj = 0; bj < 2; ++bj) { const int sc = sc0 + bj * 128, g = sc >> 6, sl = sc & 63, part = sl >> 5, cb = 8 * g + ((sl & 31) >> 2); const f32x4 v0 = acc[ai][bj][m][0], v1 = acc[ai][bj][m][1];
                        bf16* p = FCS + ((size_t)((b * 2 + part) * 64 + cb) * 4096 + n) * 4;
                        u32x2 w0, w1; w0.x = pg8::cvt_pk_bf16(v0[0], v0[1]); w0.y = pg8::cvt_pk_bf16(v0[2], v0[3]); w1.x = pg8::cvt_pk_bf16(v1[0], v1[1]); w1.y = pg8::cvt_pk_bf16(v1[2], v1[3]);
                        *(u32x2*)p = w0; *(u32x2*)(p + (size_t)4096 * 4) = w1; } }
        }
    }
};

DI void conv_fma(float (&acc)[8], const float (&w)[8], const u32x4 v) {
    acc[0] += w[0] * bflo(v.x); acc[1] += w[1] * bfhi(v.x); acc[2] += w[2] * bflo(v.y); acc[3] += w[3] * bfhi(v.y);
    acc[4] += w[4] * bflo(v.z); acc[5] += w[5] * bfhi(v.z); acc[6] += w[6] * bflo(v.w); acc[7] += w[7] * bfhi(v.w); }
DI void p3_conv(const Ctx& F) {
    const int cg = F.tid & 127, sub = F.tid >> 7;
    float w[9][8], bias[8];
#pragma unroll
    for (int t = 0; t < 9; ++t) { const f32x4 a = *(const f32x4*)(F.conv_w + t * 1024 + 8 * cg), b = *(const f32x4*)(F.conv_w + t * 1024 + 8 * cg + 4);
        w[t][0] = a.x; w[t][1] = a.y; w[t][2] = a.z; w[t][3] = a.w; w[t][4] = b.x; w[t][5] = b.y; w[t][6] = b.z; w[t][7] = b.w; }
    { const f32x4 a = *(const f32x4*)(F.conv_b + 8 * cg), b = *(const f32x4*)(F.conv_b + 8 * cg + 4);
      bias[0] = a.x; bias[1] = a.y; bias[2] = a.z; bias[3] = a.w; bias[4] = b.x; bias[5] = b.y; bias[6] = b.z; bias[7] = b.w; }
    const float osc = cg >= 64 ? 0.08838834764831845f : 1.0f;
    const u32x4 zero = (u32x4){0u, 0u, 0u, 0u};
    for (int gi = F.bid; gi < NB * 64; gi += F.G) {
        const int gr = (F.G == 256) ? ((gi & 7) * 32 + (gi >> 3)) : gi;
        const int r = gr & 63, base = (gr >> 6) * 4096, c0 = 16 * sub;
        const bool up = r > 0, dn = r < 63;
        const bf16* pm = F.PROJ() + (size_t)(base + r * 64) * 2048 + 8 * cg;
        u32x4 L[3], M[3], Rt[3];
        if (c0 > 0) { L[0] = up ? *(const u32x4*)(pm + (long)(c0 - 1 - 64) * 2048) : zero; L[1] = *(const u32x4*)(pm + (long)(c0 - 1) * 2048); L[2] = dn ? *(const u32x4*)(pm + (long)(c0 - 1 + 64) * 2048) : zero; }
        else { L[0] = zero; L[1] = zero; L[2] = zero; }
        M[0] = up ? *(const u32x4*)(pm + (long)(c0 - 64) * 2048) : zero; M[1] = *(const u32x4*)(pm + (long)c0 * 2048); M[2] = dn ? *(const u32x4*)(pm + (long)(c0 + 64) * 2048) : zero;
#pragma unroll 2
        for (int i = 0; i < 16; ++i) { const int c = c0 + i;
            if (c < 63) { Rt[0] = up ? *(const u32x4*)(pm + (long)(c + 1 - 64) * 2048) : zero; Rt[1] = *(const u32x4*)(pm + (long)(c + 1) * 2048); Rt[2] = dn ? *(const u32x4*)(pm + (long)(c + 1 + 64) * 2048) : zero; }
            else { Rt[0] = zero; Rt[1] = zero; Rt[2] = zero; }
            float acc[8];
#pragma unroll
            for (int j = 0; j < 8; ++j) acc[j] = bias[j];
#pragma unroll
            for (int a = 0; a < 3; ++a) { conv_fma(acc, w[a * 3 + 0], L[a]); conv_fma(acc, w[a * 3 + 1], M[a]); conv_fma(acc, w[a * 3 + 2], Rt[a]); }
            u32x4 o; o.x = pk2(siluf(acc[0]) * osc, siluf(acc[1]) * osc); o.y = pk2(siluf(acc[2]) * osc, siluf(acc[3]) * osc);
            o.z = pk2(siluf(acc[4]) * osc, siluf(acc[5]) * osc); o.w = pk2(siluf(acc[6]) * osc, siluf(acc[7]) * osc);
            *(u32x4*)(F.QK() + (size_t)(base + r * 64 + c) * 1024 + 8 * cg) = o;
#pragma unroll
            for (int a = 0; a < 3; ++a) { L[a] = M[a]; M[a] = Rt[a]; } }
    }
    for (int it = F.bid * 4 + sub; it < MC; it += F.G * 4) {
        const int base = MX + (it & ~255), n = it & 255;
        float acc[8];
#pragma unroll
        for (int j = 0; j < 8; ++j) acc[j] = bias[j];
#pragma unroll
        for (int b = 0; b < 3; ++b) { const int nn = n + b - 1; if (nn >= 0 && nn < 256) conv_fma(acc, w[3 + b], *(const u32x4*)(F.PROJ() + (size_t)(base + nn) * 2048 + 8 * cg)); }
        u32x4 o; o.x = pk2(siluf(acc[0]) * osc, siluf(acc[1]) * osc); o.y = pk2(siluf(acc[2]) * osc, siluf(acc[3]) * osc);
        o.z = pk2(siluf(acc[4]) * osc, siluf(acc[5]) * osc); o.w = pk2(siluf(acc[6]) * osc, siluf(acc[7]) * osc);
        *(u32x4*)(F.QK() + (size_t)(MX + it) * 1024 + 8 * cg) = o;
    }
}

DI int chunk_row0(int b, int cc) { return cc < 2 ? MX + b * 256 + cc * 128 : b * 4096 + (cc - 2) * 128; }
constexpr int TS = 288;
DI void p4_item(const Ctx& F, int it) {
    const int seq = it / NCH, cc = it % NCH, dir = seq & 1, h = (seq >> 1) & 3, b = seq >> 3, R0 = chunk_row0(b, cc);
    LAS unsigned char* KW = F.lds;
    LAS unsigned char* VV = F.lds + 36864;
    LAS float* wS = (LAS float*)(F.lds + 73728);
    const int lane = F.lane, tid = F.tid;
    u32x4 kv[4], vv[4];
#pragma unroll
    for (int i = 0; i < 4; ++i) { const int idx = tid + 512 * i, row = idx >> 4, ch = idx & 15;
        kv[i] = *(const u32x4*)(F.QK() + (size_t)(R0 + row) * 1024 + 512 + h * 128 + 8 * ch); vv[i] = *(const u32x4*)(F.PROJ() + (size_t)(R0 + row) * 2048 + 1024 + h * 128 + 8 * ch); }
    if (F.wave == 0) {
        const int p0 = 2 * lane, p1 = p0 + 1, pos0 = dir ? 127 - p0 : p0, pos1 = dir ? 127 - p1 : p1;
        const float lf0 = F.GL()[(size_t)(R0 + pos0) * 16 + dir * 8 + 4 + h], lf1 = F.GL()[(size_t)(R0 + pos1) * 16 + dir * 8 + 4 + h];
        const float li0 = F.GL()[(size_t)(R0 + pos0) * 16 + dir * 8 + h], li1 = F.GL()[(size_t)(R0 + pos1) * 16 + dir * 8 + h];
        const float s = lf0 + lf1, incl = scan_add(s, lane), excl = incl - s, b0 = excl + lf0, b1 = b0 + lf1, a0 = li0 - b0, a1 = li1 - b1;
        const float A = wave_max(fmaxf(a0, a1)), total = __shfl(incl, 63);
        wS[pos0] = __expf(a0 - A); wS[pos1] = __expf(a1 - A);
        if (lane == 0) { F.SC()[it * 2] = A; F.SC()[it * 2 + 1] = total; }
    }
    __syncthreads();
#pragma unroll
    for (int i = 0; i < 4; ++i) { const int idx = tid + 512 * i, row = idx >> 4, ch = idx & 15; const float w = wS[row];
        u32x4 o; o.x = pk2(bflo(kv[i].x) * w, bfhi(kv[i].x) * w); o.y = pk2(bflo(kv[i].y) * w, bfhi(kv[i].y) * w); o.z = pk2(bflo(kv[i].z) * w, bfhi(kv[i].z) * w); o.w = pk2(bflo(kv[i].w) * w, bfhi(kv[i].w) * w);
        *(LAS u32x4*)(KW + row * TS + 16 * ch) = o; *(LAS u32x4*)(VV + row * TS + 16 * ch) = vv[i]; }
    __syncthreads();
    const int fr = lane & 15, fq = lane >> 4, w = F.wave;
    const unsigned ab = tr_base<TS, 8>(lds_addr(VV), lane) + 32u * (unsigned)w, bb = tr_base<TS, 8>(lds_addr(KW), lane);
    f32x4 acc[8], accn = (f32x4){0.f, 0.f, 0.f, 0.f};
#pragma unroll
    for (int nt = 0; nt < 8; ++nt) acc[nt] = (f32x4){0.f, 0.f, 0.f, 0.f};
    bf16x8 ones; { const u32x4 o1 = (u32x4){0x3f803f80u, 0x3f803f80u, 0x3f803f80u, 0x3f803f80u}; ones = __builtin_bit_cast(bf16x8, o1); }
#define P4_KK(kk) { const bf16x8 a = tr2<(kk) * 32 * TS, (kk) * 32 * TS + 4 * TS>(ab); bf16x8 bfr[8]; tr2x8<(kk) * 32 * TS, 4 * TS>(bb, bfr); \
        _Pragma("unroll") for (int nt = 0; nt < 8; ++nt) acc[nt] = MFMA16(a, bfr[nt], acc[nt]); \
        const bf16x8 bw = tr2<(kk) * 32 * TS, (kk) * 32 * TS + 4 * TS>(bb + 32u * (unsigned)w); accn = MFMA16(ones, bw, accn); }
    P4_KK(0) P4_KK(1) P4_KK(2) P4_KK(3)
#undef P4_KK
    float* co = F.CHAT() + (size_t)it * 16384;
#pragma unroll
    for (int nt = 0; nt < 8; ++nt)
#pragma unroll
        for (int r = 0; r < 4; ++r) co[(16 * w + 4 * fq + r) * 128 + 16 * nt + fr] = acc[nt][r];
    if (fq == 0) F.NHAT()[(size_t)it * 128 + 16 * w + fr] = accn[0];
    __syncthreads();
}

DI int proc_chunk(int dir, int p) { return dir == 0 ? p : (p < 2 ? 1 - p : 35 - p); }
DI void p5_scan(const Ctx& F) {
    LAS float* f1S = (LAS float*)F.lds;
    LAS float* f2S = f1S + 64;
    LAS int* itS = (LAS int*)(f1S + 128);
    for (int u = F.bid; u < 32 * 8; u += F.G) {
        const int seq = u >> 3, blk = u & 7, dir = seq & 1;
        if (F.tid == 0) { float m = 0.f;
            for (int p = 0; p < NCH; ++p) { const int it = seq * NCH + proc_chunk(dir, p); const float A = F.SC()[it * 2], bl = F.SC()[it * 2 + 1], Ml = fmaxf(m, A);
                f1S[p] = __expf(m - Ml); f2S[p] = __expf(A - Ml); itS[p] = it; if (blk == 0 && p >= 2) F.MINV()[seq * 32 + p - 2] = m; m = bl + Ml; } }
        __syncthreads();
        const int qd = blk * 512 + F.tid;
        f32x4 C = (f32x4){0.f, 0.f, 0.f, 0.f};
        { f32x4 ch[2];
#pragma unroll
          for (int q = 0; q < 2; ++q) ch[q] = *(const f32x4*)(F.CHAT() + (size_t)itS[q] * 16384 + qd * 4);
#pragma unroll
          for (int q = 0; q < 2; ++q) C = C * f1S[q] + ch[q] * f2S[q]; }
#pragma unroll 1
        for (int p0 = 2; p0 < NCH; p0 += 8) {
            f32x4 ch[8];
#pragma unroll
            for (int q = 0; q < 8; ++q) ch[q] = *(const f32x4*)(F.CHAT() + (size_t)itS[p0 + q] * 16384 + qd * 4);
#pragma unroll
            for (int q = 0; q < 8; ++q) { u32x2 o; o.x = pk2(C.x, C.y); o.y = pk2(C.z, C.w); *(u32x2*)(F.CIN() + ((size_t)(seq * 32 + p0 + q - 2) * 16384 + qd * 4)) = o;
                C = C * f1S[p0 + q] + ch[q] * f2S[p0 + q]; }
        }
        if (blk == 0 && F.tid < 128) { float n = 0.f;
#pragma unroll 1
            for (int p = 0; p < NCH; ++p) { if (p >= 2) F.NIN()[(size_t)(seq * 32 + p - 2) * 128 + F.tid] = n; n = n * f1S[p] + F.NHAT()[(size_t)itS[p] * 128 + F.tid] * f2S[p]; } }
        __syncthreads();
    }
}

DI void p6_mlstm_item(const Ctx& F, int it) {
    const int c = it & 31, h = (it >> 5) & 3, b = it >> 7, R0 = b * 4096 + c * 128;
    LAS unsigned char* Q = F.lds;
    LAS unsigned char* Kx = F.lds + 36864;
    LAS unsigned char* VV = F.lds + 73728;
    LAS float* aS = (LAS float*)(F.lds + 110592);
    LAS float* MS = aS + 256; LAS float* inS = aS + 512; LAS float* flS = aS + 768; LAS float* qnS = aS + 1024; LAS float* nS = aS + 1280;
    LAS float* OT = (LAS float*)F.lds;
    const int lane = F.lane, tid = F.tid, w = F.wave, fr = lane & 15, fq = lane >> 4;
    const int seq0 = (b * 4 + h) * 2, j0 = c, j1 = 31 - c;
    u32x4 lq[4], lk[4], lv[4];
#pragma unroll
    for (int i = 0; i < 4; ++i) { const int idx = tid + 512 * i, row = idx >> 4, ch = idx & 15;
        lq[i] = *(const u32x4*)(F.QK() + (size_t)(R0 + row) * 1024 + h * 128 + 8 * ch); lk[i] = *(const u32x4*)(F.QK() + (size_t)(R0 + row) * 1024 + 512 + h * 128 + 8 * ch);
        lv[i] = *(const u32x4*)(F.PROJ() + (size_t)(R0 + row) * 2048 + 1024 + h * 128 + 8 * ch); }
    if (w < 2) {
        const int dir = w, seq = seq0 + dir, j = dir ? j1 : j0; const float m_in = F.MINV()[seq * 32 + j];
        const int p0 = 2 * lane, p1 = p0 + 1, pos0 = dir ? 127 - p0 : p0, pos1 = dir ? 127 - p1 : p1;
        const float lf0 = F.GL()[(size_t)(R0 + pos0) * 16 + dir * 8 + 4 + h], lf1 = F.GL()[(size_t)(R0 + pos1) * 16 + dir * 8 + 4 + h];
        const float li0 = F.GL()[(size_t)(R0 + pos0) * 16 + dir * 8 + h], li1 = F.GL()[(size_t)(R0 + pos1) * 16 + dir * 8 + h];
        const float s = lf0 + lf1, incl = scan_add(s, lane), excl = incl - s, b0 = excl + lf0, b1 = b0 + lf1, a0 = li0 - b0, a1 = li1 - b1;
        const float c1 = fmaxf(a0, a1), pmi = scan_max(c1, lane); float pme = __shfl_up(pmi, 1); if (lane == 0) pme = -3.0e38f;
        const float M0 = fmaxf(m_in, fmaxf(pme, a0)), M1 = fmaxf(m_in, fmaxf(pme, c1));
        aS[dir * 128 + pos0] = a0; aS[dir * 128 + pos1] = a1; MS[dir * 128 + pos0] = M0; MS[dir * 128 + pos1] = M1;
        inS[dir * 128 + pos0] = __expf(m_in - M0); inS[dir * 128 + pos1] = __expf(m_in - M1);
        flS[dir * 128 + pos0] = __expf(-b0 - M0); flS[dir * 128 + pos1] = __expf(-b1 - M1);
        nS[dir * 128 + lane] = F.NIN()[(size_t)(seq * 32 + j) * 128 + lane]; nS[dir * 128 + 64 + lane] = F.NIN()[(size_t)(seq * 32 + j) * 128 + 64 + lane];
    }
#pragma unroll
    for (int i = 0; i < 4; ++i) { const int idx = tid + 512 * i, row = idx >> 4, ch = idx & 15;
        *(LAS u32x4*)(Q + row * TS + 16 * ch) = lq[i]; *(LAS u32x4*)(Kx + row * TS + 16 * ch) = lk[i]; *(LAS u32x4*)(VV + row * TS + 16 * ch) = lv[i]; }
    u32x4 lc0[4], lc1[4];
    { const bf16* C0 = F.CIN() + (size_t)(seq0 * 32 + j0) * 16384; const bf16* C1 = F.CIN() + (size_t)((seq0 + 1) * 32 + j1) * 16384;
#pragma unroll
      for (int i = 0; i < 4; ++i) { const int idx = tid + 512 * i; lc0[i] = *(const u32x4*)(C0 + idx * 8); lc1[i] = *(const u32x4*)(C1 + idx * 8); } }
    __syncthreads();
    if (tid < 256) { const int dir = tid >> 7, t = tid & 127; float s = 0.f;
#pragma unroll
        for (int j = 0; j < 16; ++j) { const u32x4 q = *(const LAS u32x4*)(Q + t * TS + 16 * j); const LAS float* np = nS + dir * 128 + 8 * j;
            s += bflo(q.x) * np[0] + bfhi(q.x) * np[1] + bflo(q.y) * np[2] + bfhi(q.y) * np[3] + bflo(q.z) * np[4] + bfhi(q.z) * np[5] + bflo(q.w) * np[6] + bfhi(q.w) * np[7]; }
        qnS[dir * 128 + t] = s; }
    bf16x8 qf[4];
#pragma unroll
    for (int kk = 0; kk < 4; ++kk) qf[kk] = *(const LAS bf16x8*)(Q + (16 * w + fr) * TS + 64 * kk + 16 * fq);
    const int tq = 16 * w + fr;
    bf16x8 sf0[4], sf1[4]; float rs0 = 0.f, rs1 = 0.f;
    {
        f32x4 sacc[8];
#pragma unroll
        for (int nt = 0; nt < 8; ++nt) sacc[nt] = (f32x4){0.f, 0.f, 0.f, 0.f};
#pragma unroll
        for (int kk = 0; kk < 4; ++kk)
#pragma unroll
            for (int nt = 0; nt < 8; ++nt) { const bf16x8 kf = *(const LAS bf16x8*)(Kx + (16 * nt + fr) * TS + 64 * kk + 16 * fq); sacc[nt] = MFMA16(kf, qf[kk], sacc[nt]); }
        const float Mt0 = MS[tq], Mt1 = MS[128 + tq];
#pragma unroll
        for (int kk = 0; kk < 4; ++kk) { float p0[8], p1[8];
#pragma unroll
            for (int hf = 0; hf < 2; ++hf) { const int nt = 2 * kk + hf; const f32x4 a40 = *(const LAS f32x4*)(aS + 16 * nt + 4 * fq), a41 = *(const LAS f32x4*)(aS + 128 + 16 * nt + 4 * fq);
#pragma unroll
                for (int r = 0; r < 4; ++r) { const int sk = 16 * nt + 4 * fq + r;
                    const float v0 = (sk <= tq) ? sacc[nt][r] * __expf(a40[r] - Mt0) : 0.f, v1 = (sk >= tq) ? sacc[nt][r] * __expf(a41[r] - Mt1) : 0.f;
                    rs0 += v0; rs1 += v1; p0[4 * hf + r] = v0; p1[4 * hf + r] = v1; } }
            u32x4 pk; pk.x = pk2(p0[0], p0[1]); pk.y = pk2(p0[2], p0[3]); pk.z = pk2(p0[4], p0[5]); pk.w = pk2(p0[6], p0[7]); sf0[kk] = __builtin_bit_cast(bf16x8, pk);
            pk.x = pk2(p1[0], p1[1]); pk.y = pk2(p1[2], p1[3]); pk.z = pk2(p1[4], p1[5]); pk.w = pk2(p1[6], p1[7]); sf1[kk] = __builtin_bit_cast(bf16x8, pk); }
    }
    rs0 += __shfl_xor(rs0, 16); rs0 += __shfl_xor(rs0, 32); rs1 += __shfl_xor(rs1, 16); rs1 += __shfl_xor(rs1, 32);
    __syncthreads();
#pragma unroll
    for (int i = 0; i < 4; ++i) { const int idx = tid + 512 * i, row = idx >> 4, ch = idx & 15; *(LAS u32x4*)(Kx + row * TS + 16 * ch) = lc0[i]; *(LAS u32x4*)(Q + row * TS + 16 * ch) = lc1[i]; }
    u32x4 og[4];
#pragma unroll
    for (int i = 0; i < 4; ++i) { const int cidx = lane + 64 * i; og[i] = *(const u32x4*)(F.PROJ() + (size_t)(R0 + 16 * w + (cidx >> 4)) * 2048 + 1536 + h * 128 + 8 * (cidx & 15)); }
    __syncthreads();
    const unsigned vb = tr_base<TS, 4>(lds_addr(VV), lane);
    f32x4 hs[8];
#pragma unroll
    for (int nt = 0; nt < 8; ++nt) hs[nt] = (f32x4){0.f, 0.f, 0.f, 0.f};
#define P6_HALF(hv, sf, CT) { f32x4 num[4]; \
        _Pragma("unroll") for (int q4 = 0; q4 < 4; ++q4) num[q4] = (f32x4){0.f, 0.f, 0.f, 0.f}; \
        { bf16x8 vf[4]; tr2x4<0 * 32 * TS + 128 * (hv), 16 * TS>(vb, vf); _Pragma("unroll") for (int q4 = 0; q4 < 4; ++q4) num[q4] = MFMA16(sf[0], vf[q4], num[q4]); } \
        { bf16x8 vf[4]; tr2x4<1 * 32 * TS + 128 * (hv), 16 * TS>(vb, vf); _Pragma("unroll") for (int q4 = 0; q4 < 4; ++q4) num[q4] = MFMA16(sf[1], vf[q4], num[q4]); } \
        { bf16x8 vf[4]; tr2x4<2 * 32 * TS + 128 * (hv), 16 * TS>(vb, vf); _Pragma("unroll") for (int q4 = 0; q4 < 4; ++q4) num[q4] = MFMA16(sf[2], vf[q4], num[q4]); } \
        { bf16x8 vf[4]; tr2x4<3 * 32 * TS + 128 * (hv), 16 * TS>(vb, vf); _Pragma("unroll") for (int q4 = 0; q4 < 4; ++q4) num[q4] = MFMA16(sf[3], vf[q4], num[q4]); } \
        _Pragma("unroll") for (int q4 = 0; q4 < 4; ++q4) _Pragma("unroll") for (int r = 0; r < 4; ++r) hs[4 * (hv) + q4][r] += num[q4][r] * inv[r]; \
        _Pragma("unroll") for (int q4 = 0; q4 < 4; ++q4) num[q4] = (f32x4){0.f, 0.f, 0.f, 0.f}; \
        _Pragma("unroll") for (int kk = 0; kk < 4; ++kk) _Pragma("unroll") for (int q4 = 0; q4 < 4; ++q4) { \
            const bf16x8 cf = *(const LAS bf16x8*)((CT) + (16 * (4 * (hv) + q4) + fr) * TS + 64 * kk + 16 * fq); num[q4] = MFMA16(qf[kk], cf, num[q4]); } \
        _Pragma("unroll") for (int q4 = 0; q4 < 4; ++q4) _Pragma("unroll") for (int r = 0; r < 4; ++r) hs[4 * (hv) + q4][r] += num[q4][r] * inter[r]; \
        asm volatile("" ::: "memory"); }
    {   float inter[4], inv[4];
#pragma unroll
        for (int r = 0; r < 4; ++r) { const int t = 16 * w + 4 * fq + r; const float rsr = __shfl(rs0, 4 * fq + r); inter[r] = inS[t];
            const float den = rsr + inter[r] * qnS[t]; inv[r] = 1.0f / fmaxf(fabsf(den), flS[t]); inter[r] *= inv[r]; }
        P6_HALF(0, sf0, Kx) P6_HALF(1, sf0, Kx) }
    {   float inter[4], inv[4];
#pragma unroll
        for (int r = 0; r < 4; ++r) { const int t = 16 * w + 4 * fq + r; const float rsr = __shfl(rs1, 4 * fq + r); inter[r] = inS[128 + t];
            const float den = rsr + inter[r] * qnS[128 + t]; inv[r] = 1.0f / fmaxf(fabsf(den), flS[128 + t]); inter[r] *= inv[r]; }
        P6_HALF(0, sf1, Q) P6_HALF(1, sf1, Q) }
#undef P6_HALF
    __syncthreads();
#pragma unroll
    for (int r = 0; r < 4; ++r) { const int t = 16 * w + 4 * fq + r; float s = 0.f;
#pragma unroll
        for (int nt = 0; nt < 8; ++nt) s += hs[nt][r];
        const float mean = red16(s) * (1.0f / 128.0f); float q2 = 0.f;
#pragma unroll
        for (int nt = 0; nt < 8; ++nt) { const float d = hs[nt][r] - mean; q2 += d * d; }
        const float rstd = 1.0f / sqrtf(red16(q2) * (1.0f / 128.0f) + LN_EPS);
#pragma unroll
        for (int nt = 0; nt < 8; ++nt) OT[t * 132 + 16 * nt + fr] = (hs[nt][r] - mean) * rstd; }
    LDS_WAIT();
#pragma unroll
    for (int i = 0; i < 4; ++i) { const int cidx = lane + 64 * i, t = 16 * w + (cidx >> 4), v0 = 8 * (cidx & 15);
        const f32x4 x0 = *(const LAS f32x4*)(OT + t * 132 + v0), x1 = *(const LAS f32x4*)(OT + t * 132 + v0 + 4);
        const f32x4 g0 = *(const f32x4*)(F.head_g + h * 128 + v0), g1 = *(const f32x4*)(F.head_g + h * 128 + v0 + 4);
        u32x4 o; o.x = pk2(x0.x * g0.x * sigmf(bflo(og[i].x)), x0.y * g0.y * sigmf(bfhi(og[i].x))); o.y = pk2(x0.z * g0.z * sigmf(bflo(og[i].y)), x0.w * g0.w * sigmf(bfhi(og[i].y)));
        o.z = pk2(x1.x * g1.x * sigmf(bflo(og[i].z)), x1.y * g1.y * sigmf(bfhi(og[i].z))); o.w = pk2(x1.z * g1.z * sigmf(bflo(og[i].w)), x1.w * g1.w * sigmf(bfhi(og[i].w)));
        *(u32x4*)(F.MIXIN() + (size_t)(R0 + t) * 1024 + h * 128 + v0) = o; }
    __syncthreads();
}

constexpr int FS_ = 544;
DI void p6_fourier_item(const Ctx& F, int it) {
    const int xs = it & 7, ss = it >> 3, pair = (ss >> 3) * 8 + xs, a8 = ss & 7, b = pair >> 3, g = pair & 7, cb = 8 * g + a8;
    const int tid = F.tid, lane = F.lane, w = F.wave, fr = lane & 15, fq = lane >> 4;
    LAS unsigned char* XL = F.lds;
    LAS unsigned char* YL = F.lds + 69632;
    LAS float* SR = (LAS float*)F.lds;
    LAS float* SI = SR + 4096;
#pragma unroll
    for (int i = 0; i < 8; ++i) { const int idx = tid + 512 * i, part = idx >> 11, wi = idx & 2047;
        *(LAS u32x4*)(XL + (part * 64 + (wi >> 5)) * FS_ + 16 * (wi & 31)) = *(const u32x4*)(F.FCS() + (size_t)((b * 2 + part) * 64 + cb) * 16384 + wi * 8); }
    __syncthreads();
    {
        const int pr = w & 3, nh = w >> 2;
        bf16x8 a0[4], a1[4];
#pragma unroll
        for (int kk = 0; kk < 4; ++kk) { a0[kk] = *(const bf16x8*)(F.W1() + (16 * pr + fr) * 128 + 32 * kk + 8 * fq); a1[kk] = *(const bf16x8*)(F.W1() + (16 * (pr + 4) + fr) * 128 + 32 * kk + 8 * fq); }
#pragma unroll 1
        for (int hv = 0; hv < 2; ++hv) {
            const unsigned xb = tr_base<FS_, 8>(lds_addr(XL), lane) + 256u * (unsigned)nh + 128u * (unsigned)hv;
            f32x4 yr[4], yi[4];
#pragma unroll
            for (int q4 = 0; q4 < 4; ++q4) { yr[q4] = (f32x4){0.f, 0.f, 0.f, 0.f}; yi[q4] = (f32x4){0.f, 0.f, 0.f, 0.f}; }
#define FT1_KK(kk) { bf16x8 bx[4]; tr2x4<(kk) * 32 * FS_, 4 * FS_>(xb, bx); _Pragma("unroll") for (int q4 = 0; q4 < 4; ++q4) { yr[q4] = MFMA16(a0[kk], bx[q4], yr[q4]); yi[q4] = MFMA16(a1[kk], bx[q4], yi[q4]); } }
            FT1_KK(0) FT1_KK(1) FT1_KK(2) FT1_KK(3)
#undef FT1_KK
#pragma unroll
            for (int q4 = 0; q4 < 4; ++q4) { const int nt = 8 * nh + 4 * hv + q4, n = 16 * nt + fr, n2 = n >> 2, col = n & 3;
#pragma unroll
                for (int r = 0; r < 4; ++r) { const int k1 = 16 * pr + 4 * fq + r; const float ang = (float)((k1 * n2) & 4095) * (1.0f / 4096.0f); const float twx = __builtin_amdgcn_cosf(ang), twy = __builtin_amdgcn_sinf(ang);
                    const float y2r = yr[q4][r] * twx + yi[q4][r] * twy, y2i = yi[q4][r] * twx - yr[q4][r] * twy;
                    *(LAS bf16*)(YL + (0 * 64 + n2) * FS_ + (k1 * 4 + col) * 2) = (bf16)f2bf(y2r); *(LAS bf16*)(YL + (1 * 64 + n2) * FS_ + (k1 * 4 + col) * 2) = (bf16)f2bf(y2i); } }
        }
    }
    __syncthreads();
    {
        const int mt = w & 3, nh = w >> 2;
        bf16x8 ar[4], ai[4];
#pragma unroll
        for (int kk = 0; kk < 4; ++kk) { ar[kk] = *(const bf16x8*)(F.W2() + (16 * mt + fr) * 128 + 32 * kk + 8 * fq); ai[kk] = *(const bf16x8*)(F.W2I() + (16 * mt + fr) * 128 + 32 * kk + 8 * fq); }
        bf16* orow0 = F.MIXIN() + (size_t)(b * 4096) * 1024 + 512 + 64 * g;
#pragma unroll 1
        for (int hv = 0; hv < 2; ++hv) {
            const unsigned yb = tr_base<FS_, 8>(lds_addr(YL), lane) + 256u * (unsigned)nh + 128u * (unsigned)hv;
            f32x4 xr[4], xi[4];
#pragma unroll
            for (int q4 = 0; q4 < 4; ++q4) { xr[q4] = (f32x4){0.f, 0.f, 0.f, 0.f}; xi[q4] = (f32x4){0.f, 0.f, 0.f, 0.f}; }
#define FT2_KK(kk) { bf16x8 by[4]; tr2x4<(kk) * 32 * FS_, 4 * FS_>(yb, by); _Pragma("unroll") for (int q4 = 0; q4 < 4; ++q4) { xr[q4] = MFMA16(ar[kk], by[q4], xr[q4]); if (a8 == 0) xi[q4] = MFMA16(ai[kk], by[q4], xi[q4]); } }
            FT2_KK(0) FT2_KK(1) FT2_KK(2) FT2_KK(3)
#undef FT2_KK
#pragma unroll
            for (int q4 = 0; q4 < 4; ++q4) { const int nt = 8 * nh + 4 * hv + q4, n = 16 * nt + fr, k1 = n >> 2, col = n & 3, j = 4 * a8 + col;
#pragma unroll
                for (int r = 0; r < 4; ++r) { const int k2 = 16 * mt + 4 * fq + r, k = k1 + 64 * k2;
                    if (j == 0) { SR[k] = xr[q4][r]; SI[k] = xi[q4][r]; }
                    else { const bf16 ov = (bf16)f2bf(xr[q4][r] * (1.0f / 512.0f)); orow0[(size_t)k * 1024 + j] = ov; orow0[(size_t)((4096 - k) & 4095) * 1024 + 64 - j] = ov; } } }
        }
    }
    __syncthreads();
    if (a8 == 0) {
        bf16* orow0 = F.MIXIN() + (size_t)(b * 4096) * 1024 + 512 + 64 * g;
#pragma unroll
        for (int i = 0; i < 8; ++i) { const int k = tid + 512 * i, km = (4096 - k) & 4095;
            orow0[(size_t)k * 1024] = (bf16)f2bf((SR[k] + SR[km]) * (0.5f / 512.0f)); orow0[(size_t)k * 1024 + 32] = (bf16)f2bf((SI[k] + SI[km]) * (-0.5f / 512.0f)); }
        __syncthreads();
    }
}

struct OutOrder {
    struct Unit { int pm, pn; };
    int G, c; const bf16* Bt;
    DI bool next(int i, Unit& u) const { const int L = i * G + c; if (L >= 256) return false; pg8::static_tile(L, 64, 4, u.pm, u.pn); return true; }
    DI void a_off(const Unit& u, const int (&R)[2], const int (&C)[2], unsigned (&off)[2][2]) const {
#pragma unroll
        for (int h = 0; h < 2; ++h)
#pragma unroll
            for (int i = 0; i < 2; ++i) off[h][i] = (unsigned)((u.pm * 256 + h * 128 + R[i]) * 1024 + C[i]) * 2u; }
    DI const char* b_ptr(const Unit& u) const { return (const char*)(Bt + (size_t)u.pn * 256 * 1024); }
};
struct EpiMix {
    static constexpr bool PERM = true;
    bf16* Cm;
    DI void operator()(const f32x4 (&acc)[2][2][4][2], const OutOrder::Unit& u, int wr, int wc, int fr, int fq) const {
        const int row0 = u.pm * 256 + wr * 64 + fr, col0 = u.pn * 256 + wc * 32 + 8 * fq;
#pragma unroll
        for (int ai = 0; ai < 2; ++ai)
#pragma unroll
            for (int m = 0; m < 4; ++m) { bf16* rowp = Cm + (size_t)(row0 + ai * 128 + m * 16) * 1024 + col0;
#pragma unroll
                for (int bj = 0; bj < 2; ++bj) { const f32x4 v0 = acc[ai][bj][m][0], v1 = acc[ai][bj][m][1];
                    u32x4 w; w.x = pg8::cvt_pk_bf16(v0[0], v0[1]); w.y = pg8::cvt_pk_bf16(v0[2], v0[3]); w.z = pg8::cvt_pk_bf16(v1[0], v1[1]); w.w = pg8::cvt_pk_bf16(v1[2], v1[3]);
                    *(u32x4*)(rowp + bj * 128) = w; } }
    }
};

DI void p8_rows(const Ctx& F) {
    LAS float* modL = (LAS float*)F.lds;
    LAS bf16* tH = (LAS bf16*)(F.lds + 49152);
    LAS float* PL = (LAS float*)(F.lds + 115200);
    LAS int* lcnt = (LAS int*)(F.lds + 123392);
    LAS int* lbase = (LAS int*)(F.lds + 123648);
    LAS int* selP = (LAS int*)(F.lds + 123904);
    LAS float* selG = (LAS float*)(F.lds + 132096);
    const int lane = F.lane, w = F.wave, tid = F.tid, fr = lane & 15, fq = lane >> 4;
    const int nt = w & 3, kh = w >> 2;
    for (int i = tid; i < 4 * 3072; i += 512) modL[i] = F.MOD()[(i / 3072) * 6144 + 2048 + (i % 3072)];
    f16x8 wbh[16];
#pragma unroll
    for (int kk = 0; kk < 16; ++kk) wbh[kk] = *(const f16x8*)(F.WRH() + (size_t)(16 * nt + fr) * 1024 + 512 * kh + 32 * kk + 8 * fq);
    const float rbias = F.router_bias[lane];
    if (tid < 64) lcnt[tid] = 0;
    __syncthreads();
    int gi = 0;
    f32x4 xa[2][4]; u32x2 ma[2][4];
#define P8_LOAD(g16_) { const int r0_ = 16 * (g16_) + 2 * w; _Pragma("unroll") for (int rr = 0; rr < 2; ++rr) _Pragma("unroll") for (int m = 0; m < 4; ++m) { \
        xa[rr][m] = __builtin_nontemporal_load((const f32x4*)(F.x + (size_t)(r0_ + rr) * 1024 + 256 * m + 4 * lane)); ma[rr][m] = *(const u32x2*)(F.MIXB() + (size_t)(r0_ + rr) * 1024 + 256 * m + 4 * lane); } }
    if (F.bid < MX / 16) P8_LOAD(F.bid)
    for (int g16 = F.bid; g16 < MX / 16; g16 += F.G, ++gi) {
        const int b = (16 * g16) >> 12; const LAS float* md = modL + b * 3072;
        const int row0 = 16 * g16 + 2 * w;
#pragma unroll
        for (int rr = 0; rr < 2; ++rr) {
            const int lr = 2 * w + rr, row = row0 + rr;
            f32x4 v[4]; float s = 0.f;
#pragma unroll
            for (int m = 0; m < 4; ++m) { const f32x4 gt = *(const LAS f32x4*)(md + 256 * m + 4 * lane); const f32x4 mv = (f32x4){bflo(ma[rr][m].x), bfhi(ma[rr][m].x), bflo(ma[rr][m].y), bfhi(ma[rr][m].y)};
                v[m] = xa[rr][m] * ALPHA + gt * mv; s += (v[m].x + v[m].y) + (v[m].z + v[m].w); }
            float mean = wave_sum(s) * (1.0f / 1024.0f), s2 = 0.f;
#pragma unroll
            for (int m = 0; m < 4; ++m) { v[m] = v[m] - mean; s2 += (v[m].x * v[m].x + v[m].y * v[m].y) + (v[m].z * v[m].z + v[m].w * v[m].w); }
            float rstd = 1.0f / sqrtf(wave_sum(s2) * (1.0f / 1024.0f) + LN_EPS);
            s = 0.f;
#pragma unroll
            for (int m = 0; m < 4; ++m) { const int k = 256 * m + 4 * lane; const f32x4 gg = *(const f32x4*)(F.ln1_g + k), bb = *(const f32x4*)(F.ln1_b + k);
                v[m] = v[m] * rstd * gg + bb; u32x2 xo; xo.x = pk2(v[m].x, v[m].y); xo.y = pk2(v[m].z, v[m].w); *(u32x2*)(F.X1() + (size_t)row * 1024 + k) = xo; s += (v[m].x + v[m].y) + (v[m].z + v[m].w); }
            mean = wave_sum(s) * (1.0f / 1024.0f); s2 = 0.f;
#pragma unroll
            for (int m = 0; m < 4; ++m) { v[m] = v[m] - mean; s2 += (v[m].x * v[m].x + v[m].y * v[m].y) + (v[m].z * v[m].z + v[m].w * v[m].w); }
            rstd = 1.0f / sqrtf(wave_sum(s2) * (1.0f / 1024.0f) + LN_EPS);
            bf16* trow = F.T() + (size_t)row * 1024;
#pragma unroll
            for (int m = 0; m < 4; ++m) { const int k = 256 * m + 4 * lane; const f32x4 sh = *(const LAS f32x4*)(md + 1024 + k), sc = *(const LAS f32x4*)(md + 2048 + k);
                const f32x4 t = v[m] * rstd * (sc + 1.0f) + sh;
                u32x2 oh; oh.x = pk2(t.x, t.y); oh.y = pk2(t.z, t.w); *(u32x2*)(trow + k) = oh;
                u32x2 of; of.x = pkh2(t.x, t.y); of.y = pkh2(t.z, t.w); *(LAS u32x2*)(tH + lr * 1032 + k) = of; }
        }
        if (g16 + F.G < MX / 16) P8_LOAD(g16 + F.G)
        __syncthreads();
        {
            f32x4 a0 = (f32x4){0.f, 0.f, 0.f, 0.f}, a2 = a0;
#pragma unroll
            for (int kk = 0; kk < 16; kk += 2) { const f16x8 h0 = *(const LAS f16x8*)(tH + fr * 1032 + 512 * kh + 32 * kk + 8 * fq), h1 = *(const LAS f16x8*)(tH + fr * 1032 + 512 * kh + 32 * (kk + 1) + 8 * fq);
                a0 = __builtin_amdgcn_mfma_f32_16x16x32_f16(h0, wbh[kk], a0, 0, 0, 0); a2 = __builtin_amdgcn_mfma_f32_16x16x32_f16(h1, wbh[kk + 1], a2, 0, 0, 0); }
#pragma unroll
            for (int r = 0; r < 4; ++r) PL[(kh * 16 + 4 * fq + r) * 64 + 16 * nt + fr] = a0[r] + a2[r];
        }
        __syncthreads();
#pragma unroll 1
        for (int rr = 0; rr < 2; ++rr) {
            const int lr = 2 * w + rr; const float logit = PL[lr * 64 + lane] + PL[(16 + lr) * 64 + lane];
            const float score = 1.0f / (1.0f + expf(-logit)); float sb = score + rbias; sb = (sb == sb) ? sb : -1.0f; int rank = 0;
#pragma unroll 8
            for (int j = 0; j < 64; ++j) { const float o = __builtin_bit_cast(float, __builtin_amdgcn_readlane(__builtin_bit_cast(int, sb), j)); rank += (o > sb || (o == sb && j < lane)) ? 1 : 0; }
            const bool sel = rank < TOPK; const float ssum = wave_sum(sel ? score : 0.f);
            if (sel) { const int lidx = __hip_atomic_fetch_add(lcnt + lane, 1, __ATOMIC_RELAXED, __HIP_MEMORY_SCOPE_WORKGROUP);
                selP[(gi * 16 + lr) * 8 + rank] = lane | (lidx << 8); selG[(gi * 16 + lr) * 8 + rank] = 2.5f * score / ssum; }
        }
        __syncthreads();
    }
    if (tid < 64) lbase[tid] = (int)__hip_atomic_fetch_add(F.ctl() + (F.dry ? CW_CNT2 : CW_CNT) + 16 * tid, (unsigned)lcnt[tid], __ATOMIC_RELAXED, __HIP_MEMORY_SCOPE_AGENT);
    __syncthreads();
    for (int i = tid; i < gi * 128; i += 512) { const int lr = i >> 3, k = i & 7, row = 16 * (F.bid + (lr >> 4) * F.G) + (lr & 15);
        const int p = selP[i], e = p & 255, pos = lbase[e] + (p >> 8);
        F.ROWTAB()[(size_t)e * 16384 + pos] = row; F.EIDX()[row * 8 + k] = e; F.EPOS()[row * 8 + k] = pos; F.EGATE()[row * 8 + k] = selG[i]; }
#undef P8_LOAD
}

DI void moe_tiles_to_lds(const Ctx& F) {
    LAS int* tb = (LAS int*)(F.lds + LDS_TB); LAS int* cn = tb + 66; LAS int* sxb = tb + 132;
    if (F.tid < 64) { const int c = (int)__hip_atomic_load(F.ctl() + CW_CNT + 16 * F.tid, __ATOMIC_RELAXED, __HIP_MEMORY_SCOPE_AGENT); const int nt = (c + 255) >> 8;
        float fi = scan_add((float)nt, F.lane); const int incl = (int)(fi + 0.5f);
        tb[F.tid] = incl - nt; cn[F.tid] = c; if (F.tid == 63) { tb[64] = incl; tb[65] = incl + 64; cn[64] = MX; } }
    __syncthreads();
    if (F.tid == 0) { const int T = tb[65]; int prev = 0; sxb[0] = 0;
        for (int x = 0; x < 8; ++x) { int sh = ((x + 1) * T + 4) / 8 - tb[8 * x + 8]; sh = sh < prev ? prev : sh; sh = sh > 64 ? 64 : sh; if (x == 7) sh = 64; sxb[x + 1] = sh; prev = sh; } }
    __syncthreads();
}
DI int moe_find(const LAS int* tb, int tt) { int e = 0;
#pragma unroll
    for (int s = 64; s >= 1; s >>= 1) if (e + s <= 64 && tb[e + s] <= tt) e += s;
    return e; }
DI bool moe_unit(const LAS int* tb, int G, int c, int i, int upt  , int& tt, int& pn, int& e) {
    const LAS int* sxb = tb + 132; const int x = c & 7, idx = (c >> 3) + i * (G >> 3);
    const int own = upt * (tb[8 * x + 8] - tb[8 * x]), sh = upt * (sxb[x + 1] - sxb[x]);
    if (idx >= own + sh) return false;
    if (idx < own) { tt = tb[8 * x] + idx / upt; pn = idx % upt; e = 0;
#pragma unroll
        for (int q = 1; q < 8; ++q) e += (tb[8 * x + q] <= tt) ? 1 : 0;
        e += 8 * x; }
    else { const int su = idx - own; tt = tb[64] + sxb[x] + su / upt; pn = su % upt; e = 64; }
    return true;
}
struct Moe1Order {
    struct Unit { int tt, pn, e, slot; };
    int G, c; const bf16* WguT; const LAS int* tb; const LAS int* rowL;
    DI bool next(int i, Unit& u) const { if (i >= MOE1_SLOTS) return false; u.slot = i; return moe_unit(tb, G, c, i, 2, u.tt, u.pn, u.e); }
    DI void a_off(const Unit& u, const int (&R)[2], const int (&C)[2], unsigned (&off)[2][2]) const {
#pragma unroll
        for (int h = 0; h < 2; ++h)
#pragma unroll
            for (int i = 0; i < 2; ++i) off[h][i] = (unsigned)(rowL[u.slot * 256 + h * 128 + R[i]] * 1024 + C[i]) * 2u; }
    DI const char* b_ptr(const Unit& u) const { return (const char*)(WguT + ((size_t)u.e * 512 + u.pn * 256) * 1024); }
};
struct EpiGu {
    static constexpr bool PERM = true;
    bf16* HB;
    DI void operator()(const f32x4 (&acc)[2][2][4][2], const Moe1Order::Unit& u, int wr, int wc, int fr, int fq) const {
        const int row0 = u.tt * 256 + wr * 64 + fr, col0 = u.pn * 128 + wc * 32 + 8 * fq;
#pragma unroll
        for (int ai = 0; ai < 2; ++ai)
#pragma unroll
            for (int m = 0; m < 4; ++m) { const f32x4 g0 = acc[ai][0][m][0], g1 = acc[ai][0][m][1], u0 = acc[ai][1][m][0], u1 = acc[ai][1][m][1];
                u32x4 w; w.x = pg8::cvt_pk_bf16(siluf(g0[0]) * u0[0], siluf(g0[1]) * u0[1]); w.y = pg8::cvt_pk_bf16(siluf(g0[2]) * u0[2], siluf(g0[3]) * u0[3]);
                w.z = pg8::cvt_pk_bf16(siluf(g1[0]) * u1[0], siluf(g1[1]) * u1[1]); w.w = pg8::cvt_pk_bf16(siluf(g1[2]) * u1[2], siluf(g1[3]) * u1[3]);
                *(u32x4*)(HB + (size_t)(row0 + ai * 128 + m * 16) * 256 + col0) = w; }
    }
};
struct Moe2Order {
    struct Unit { int tt, pn, e; };
    int G, c; const bf16* WdT; const LAS int* tb;
    DI bool next(int i, Unit& u) const { return moe_unit(tb, G, c, i, 4, u.tt, u.pn, u.e); }
    DI void a_off(const Unit& u, const int (&R)[2], const int (&C)[2], unsigned (&off)[2][2]) const {
#pragma unroll
        for (int h = 0; h < 2; ++h)
#pragma unroll
            for (int i = 0; i < 2; ++i) off[h][i] = (unsigned)((u.tt * 256 + h * 128 + R[i]) * 256 + C[i]) * 2u; }
    DI const char* b_ptr(const Unit& u) const { return (const char*)(WdT + ((size_t)u.e * 1024 + u.pn * 256) * 256); }
};
constexpr float YB_SCALE = 32.0f;
struct EpiDn {
    static constexpr bool PERM = true;
    unsigned char* YB;
    DI void operator()(const f32x4 (&acc)[2][2][4][2], const Moe2Order::Unit& u, int wr, int wc, int fr, int fq) const {
        const int row0 = u.tt * 256 + wr * 64 + fr, col0 = u.pn * 256 + wc * 32 + 8 * fq;
#pragma unroll
        for (int ai = 0; ai < 2; ++ai)
#pragma unroll
            for (int m = 0; m < 4; ++m) { unsigned char* rowp = YB + (size_t)(row0 + ai * 128 + m * 16) * 1024 + col0;
#pragma unroll
                for (int bj = 0; bj < 2; ++bj) { f32x4 v0 = acc[ai][bj][m][0] * YB_SCALE, v1 = acc[ai][bj][m][1] * YB_SCALE;
#pragma unroll
                    for (int q = 0; q < 4; ++q) { v0[q] = __builtin_amdgcn_fmed3f(v0[q], -448.f, 448.f); v1[q] = __builtin_amdgcn_fmed3f(v1[q], -448.f, 448.f); }
                    int p0 = __builtin_amdgcn_cvt_pk_fp8_f32(v0[0], v0[1], 0, false); p0 = __builtin_amdgcn_cvt_pk_fp8_f32(v0[2], v0[3], p0, true);
                    int p1 = __builtin_amdgcn_cvt_pk_fp8_f32(v1[0], v1[1], 0, false); p1 = __builtin_amdgcn_cvt_pk_fp8_f32(v1[2], v1[3], p1, true);
                    u32x2 w; w.x = (unsigned)p0; w.y = (unsigned)p1; *(u32x2*)(rowp + bj * 128) = w; } }
    }
};
DI void p9_fill_rows(const Ctx& F) {
    const LAS int* tb = (const LAS int*)(F.lds + LDS_TB); const LAS int* cn = tb + 66; LAS int* rowL = (LAS int*)(F.lds + LDS_ROWL);
    for (int i = 0; i < MOE1_SLOTS; ++i) { int tt, pn, e; if (!moe_unit(tb, F.G, F.bid, i, 2, tt, pn, e)) break; const int rt = tt - tb[e];
        if (F.tid < 256) { const int r = 256 * rt + F.tid; rowL[i * 256 + F.tid] = e < 64 ? (r < cn[e] ? F.ROWTAB()[(size_t)e * 16384 + r] : 0) : r; } }
    __syncthreads();
}
DI void p11_acc(float (&acc)[16], float g, const u32x4 q) {
    const unsigned wv[4] = {q.x, q.y, q.z, q.w};
#pragma unroll
    for (int i = 0; i < 4; ++i) { const f32x2 lo = __builtin_amdgcn_cvt_pk_f32_fp8((int)wv[i], false), hi = __builtin_amdgcn_cvt_pk_f32_fp8((int)wv[i], true);
        acc[4 * i] += g * lo.x; acc[4 * i + 1] += g * lo.y; acc[4 * i + 2] += g * hi.x; acc[4 * i + 3] += g * hi.y; } }
DI void p11_combine(const Ctx& F) {
    LAS float* modL = (LAS float*)F.lds;
    const LAS int* tb = (const LAS int*)(F.lds + LDS_TB);
    for (int i = F.tid; i < 4 * 1024; i += 512) modL[i] = F.MOD()[(i >> 10) * 6144 + 5120 + (i & 1023)];
    __syncthreads();
    const int lane = F.lane, gw = F.bid * 8 + F.wave, NGW = F.G * 8;
    const unsigned char* YB8 = (const unsigned char*)F.YB();
    u32x4 q[9], qn[9]; u32x4 xv[2], xvn[2]; float gg[9], ggn[9]; int ei[8], pi[8]; float gi[8];
#define P11_IDX(r) { const int* ep_ = F.EIDX() + (r) * 8; const int* pp_ = F.EPOS() + (r) * 8; const float* gp_ = F.EGATE() + (r) * 8; \
        _Pragma("unroll") for (int k = 0; k < 8; ++k) { ei[k] = ep_[k]; pi[k] = pp_[k]; gi[k] = gp_[k]; } }
#define P11_ISSUE(r, Q, X, G) { _Pragma("unroll") for (int k = 0; k < 8; ++k) { Q[k] = *(const u32x4*)(YB8 + (size_t)(tb[ei[k]] * 256 + pi[k]) * 1024 + 16 * lane); G[k] = gi[k] * (1.0f / YB_SCALE); } \
        Q[8] = *(const u32x4*)(YB8 + (size_t)(tb[64] * 256 + (r)) * 1024 + 16 * lane); G[8] = 1.0f / YB_SCALE; \
        _Pragma("unroll") for (int i = 0; i < 2; ++i) X[i] = *(const u32x4*)(F.X1() + (size_t)(r) * 1024 + 16 * lane + 8 * i); }
    int row = gw;
    if (row < MX) { P11_IDX(row) P11_ISSUE(row, q, xv, gg) if (row + NGW < MX) P11_IDX(row + NGW) }
    while (row < MX) {
        const int nrow = row + NGW;
        if (nrow < MX) { P11_ISSUE(nrow, qn, xvn, ggn) if (nrow + NGW < MX) P11_IDX(nrow + NGW) }
        float* orow = F.out + (size_t)row * 1024; const LAS float* md = modL + (row >> 12) * 1024;
        float acc[16];
#pragma unroll
        for (int j = 0; j < 16; ++j) acc[j] = 0.f;
#pragma unroll
        for (int k = 0; k < 9; ++k) p11_acc(acc, gg[k], q[k]);
        float v[16]; float s = 0.f;
#pragma unroll
        for (int i = 0; i < 4; ++i) { const f32x4 g4 = *(const LAS f32x4*)(md + 16 * lane + 4 * i); const unsigned xw0 = (i & 1) ? xv[i >> 1].z : xv[i >> 1].x, xw1 = (i & 1) ? xv[i >> 1].w : xv[i >> 1].y;
            v[4 * i] = ALPHA * bflo(xw0) + g4.x * acc[4 * i]; v[4 * i + 1] = ALPHA * bfhi(xw0) + g4.y * acc[4 * i + 1]; v[4 * i + 2] = ALPHA * bflo(xw1) + g4.z * acc[4 * i + 2]; v[4 * i + 3] = ALPHA * bfhi(xw1) + g4.w * acc[4 * i + 3];
            s += (v[4 * i] + v[4 * i + 1]) + (v[4 * i + 2] + v[4 * i + 3]); }
        const float mean = wave_sum(s) * (1.0f / 1024.0f); float s2 = 0.f;
#pragma unroll
        for (int j = 0; j < 16; ++j) { v[j] -= mean; s2 += v[j] * v[j]; }
        const float rstd = 1.0f / sqrtf(wave_sum(s2) * (1.0f / 1024.0f) + LN_EPS);
#pragma unroll
        for (int i = 0; i < 4; ++i) { const int c0 = 16 * lane + 4 * i; const f32x4 ga = *(const f32x4*)(F.ln2_g + c0), ba = *(const f32x4*)(F.ln2_b + c0);
            f32x4 o; o.x = v[4 * i] * rstd * ga.x + ba.x; o.y = v[4 * i + 1] * rstd * ga.y + ba.y; o.z = v[4 * i + 2] * rstd * ga.z + ba.z; o.w = v[4 * i + 3] * rstd * ga.w + ba.w;
            *(f32x4*)(orow + c0) = o; }
#pragma unroll
        for (int k = 0; k < 9; ++k) { q[k] = qn[k]; gg[k] = ggn[k]; }
#pragma unroll
        for (int i = 0; i < 2; ++i) xv[i] = xvn[i];
        row = nrow;
    }
#undef P11_IDX
#undef P11_ISSUE
}

constexpr int NPHASE = 12;
__global__ void __launch_bounds__(512, 2) mk_fwd(Args args) {
    extern __shared__ __attribute__((aligned(16))) unsigned char lds_raw[];
    Ctx F;
    F.lds = (LAS unsigned char*)lds_raw;
    F.tid = threadIdx.x; F.lane = F.tid & 63; F.wave = __builtin_amdgcn_readfirstlane(F.tid >> 6); F.G = gridDim.x; F.bid = blockIdx.x; F.dry = args.pad;
    F.x = args.in[0]; F.c = args.in[1]; F.ctx = args.in[2]; F.c_ctx = args.in[3]; F.w_ada = args.in[4]; F.b_ada = args.in[5]; F.w_in = args.in[6]; F.conv_w = args.in[7]; F.conv_b = args.in[8];
    F.gate_b = args.in[9]; F.head_g = args.in[10]; F.w_out = args.in[11]; F.ln1_g = args.in[12]; F.ln1_b = args.in[13]; F.w_router = args.in[14]; F.router_bias = args.in[15];
    F.w_egu = args.in[16]; F.w_ed = args.in[17]; F.w_sgu = args.in[18]; F.w_sd = args.in[19]; F.ln2_g = args.in[20]; F.ln2_b = args.in[21];
    F.out = args.out; F.ws = args.ws;
    volatile LAS unsigned* MISC = (volatile LAS unsigned*)(F.lds + LDS_MISC);
    for (int u = F.tid; u < (LDS_BYTES - LDS_MISC) / 4; u += 512) MISC[u] = 0u;
    __syncthreads();
    XcdBarrier bar; bar.bar = F.ctl() + CW_BAR; bar.x = 0; bar.st = nullptr;
    if (MK_N_LAUNCHES == 1) bar = xcd_barrier_post(F.ctl() + CW_BAR, MISC + 8);
    const int lo = args.ph_lo, hi = args.ph_hi;
#define IN(k) (lo <= (k) && (k) < hi)
#define SEAM(k) do { if (IN(k) && IN((k) + 1)) xcd_barrier(bar); } while (0)
#ifndef PROBE_REP
#define PROBE_REP -1
#endif

    if (IN(0)) { p0_prologue(F); }
    if (IN(1)) { p1_lnmod(F); } SEAM(1);
    if (IN(2)) { ProjOrder S{F.G, F.bid, F.WINT()}; EpiProj E{F.PROJ(), F.FCS()}; pg8::gemm_phase<EpiProj, ProjOrder>(F.lds, (const char*)F.XN(), 1024, S, E);
        if (F.G == 256 && MK_N_LAUNCHES == 1 && F.bid >= P2_BUSY)
            p0_transposes(F, (LAS float*)(F.lds + F.wave * 17408), T_EARLY + (F.bid - P2_BUSY) * 8 + F.wave, (256 - P2_BUSY) * 8, T_ALL); } SEAM(2);
    if (IN(3)) { p3_conv(F); } SEAM(3);
    if (IN(4)) { for (int it = F.bid; it < NITEM4; it += F.G) p4_item(F, it); } SEAM(4);
    if (IN(5)) { p5_scan(F); } SEAM(5);
    if (IN(6)) { if (F.dry != 2) for (int it = F.bid; it < 512; it += F.G) p6_mlstm_item(F, it);
                 if (F.dry != 1) for (int it = F.bid; it < 256; it += F.G) p6_fourier_item(F, it); } SEAM(6);
    if (IN(7)) { OutOrder S{F.G, F.bid, F.WOUTT()}; EpiMix E{F.MIXB()}; pg8::gemm_phase<EpiMix, OutOrder>(F.lds, (const char*)F.MIXIN(), 1024, S, E); } SEAM(7);
    if (IN(8)) { p8_rows(F); } SEAM(8);
    if (IN(9)) { moe_tiles_to_lds(F); p9_fill_rows(F);
        Moe1Order S{F.G, F.bid, F.WGUT(), (const LAS int*)(F.lds + LDS_TB), (const LAS int*)(F.lds + LDS_ROWL)}; EpiGu E{F.HB()};
        pg8::gemm_phase<EpiGu, Moe1Order>(F.lds, (const char*)F.T(), 1024, S, E); } SEAM(9);
    if (IN(10)) { moe_tiles_to_lds(F); Moe2Order S{F.G, F.bid, F.WDT(), (const LAS int*)(F.lds + LDS_TB)}; EpiDn E{(unsigned char*)F.YB()};
        pg8::gemm_phase<EpiDn, Moe2Order>(F.lds, (const char*)F.HB(), 256, S, E); } SEAM(10);
    if (IN(11)) { moe_tiles_to_lds(F); p11_combine(F); }
#undef IN
#undef SEAM
}

extern "C" void kernel_launch(void* const* d_in, const int* in_sizes, int n_in, void* d_out, int out_size, void* d_ws, size_t ws_size, hipStream_t stream) {
    static int grid = 0;
    if (grid == 0) {
        if (n_in != 22 || out_size != MX * DM || ws_size < WS_END) { fprintf(stderr, "kernel_launch: unexpected problem (n_in %d, out %d, ws %zu)\n", n_in, out_size, ws_size); grid = -1; return; }
        int dev = 0, cus = 0, per_cu = 0;
        if (hipGetDevice(&dev) != hipSuccess || hipDeviceGetAttribute(&cus, hipDeviceAttributeMultiprocessorCount, dev) != hipSuccess) { grid = -1; return; }
        if (hipFuncSetAttribute((const void*)mk_fwd, hipFuncAttributeMaxDynamicSharedMemorySize, LDS_BYTES) != hipSuccess) { fprintf(stderr, "kernel_launch: hipFuncSetAttribute failed\n"); grid = -1; return; }
        if (hipOccupancyMaxActiveBlocksPerMultiprocessor(&per_cu, (const void*)mk_fwd, 512, LDS_BYTES) != hipSuccess || per_cu < 1) { fprintf(stderr, "kernel_launch: occupancy query says %d\n", per_cu); per_cu = 1; }
        (void)hipGetLastError();
        grid = cus;
        if (grid > 256) grid = 256;
        grid &= ~7;
    }
    if (grid < 0) return;
    (void)in_sizes;
    if (hipMemsetAsync((char*)d_ws + WS_CTL, 0, CTL_ZERO_BYTES, stream) != hipSuccess) return;
    Args a{};
    for (int i = 0; i < 22; ++i) a.in[i] = (const float*)d_in[i];
    a.out = (float*)d_out; a.ws = (unsigned char*)d_ws;
    for (int li = 0; li < MK_N_LAUNCHES; ++li) {
        a.ph_lo = (MK_N_LAUNCHES == 1) ? 0 : li; a.ph_hi = (MK_N_LAUNCHES == 1) ? NPHASE : li + 1; a.li = li; a.pad = 0;
        if (MK_N_LAUNCHES > 1 && li == PROBE_REP) { a.pad = 1; hipLaunchKernelGGL(mk_fwd, dim3(grid), dim3(512), LDS_BYTES, stream, a); a.pad = 0; }
        if (MK_N_LAUNCHES > 1 && li == PROBE_REP - 200) { a.pad = 2; hipLaunchKernelGGL(mk_fwd, dim3(grid), dim3(512), LDS_BYTES, stream, a); a.pad = 0; }
        if (MK_N_LAUNCHES > 1 && li == PROBE_REP - 100) { a.pad = 1; for (int q = 0; q < 3; ++q) hipLaunchKernelGGL(mk_fwd, dim3(grid), dim3(512), LDS_BYTES, stream, a); a.pad = 0; }
        hipLaunchKernelGGL(mk_fwd, dim3(grid), dim3(512), LDS_BYTES, stream, a);
    }
}
```

```cpp
#include <hip/hip_runtime.h>
#include <cstdio>
#include <cstdint>

#ifndef GEMM_SP2
#define GEMM_SP2 true
#endif
#ifndef GEMM_ALIGN
#define GEMM_ALIGN false
#endif
#ifndef MK_N_LAUNCHES
#define MK_N_LAUNCHES 1
#endif

#define LAS __attribute__((address_space(3)))
#define DI __device__ __forceinline__
typedef unsigned short bf16;
typedef float f32x4 __attribute__((ext_vector_type(4)));
typedef float f32x2 __attribute__((ext_vector_type(2)));
typedef short bf16x8 __attribute__((ext_vector_type(8)));
typedef unsigned u32x4 __attribute__((ext_vector_type(4)));
typedef unsigned u32x2 __attribute__((ext_vector_type(2)));

constexpr int NB = 4, SEQ = 4096, DM = 1024, CTXL = 256;
constexpr int MX = NB * SEQ;
constexpr int MC = NB * CTXL;
constexpr int MALL = MX + MC;
constexpr int NH = 4, HD = 128;
constexpr int DINP = 2576;
constexpr int NE = 64, TOPK = 8, DE = 256;
constexpr int NCH = 34;
constexpr int NITEM4 = 32 * NCH;
constexpr float LN_EPS = 1e-5f;
constexpr float ALPHA = 1.189207115002721f;
constexpr int MAXTILES = 640;

constexpr size_t MiB = 1u << 20;
constexpr size_t WS_CTL = 0, CTL_ZERO_BYTES = 1 * MiB;
constexpr size_t WS_MODP = 446 * MiB;
constexpr size_t WS_TAB = 2 * MiB;
constexpr size_t WS_GL = 3 * MiB;
constexpr size_t WS_ROWTAB = 5 * MiB;
constexpr size_t WS_EIDX = 9 * MiB;
constexpr size_t WS_EPOS = 9 * MiB + 512 * 1024;
constexpr size_t WS_EGATE = 10 * MiB;
constexpr size_t WS_SC = 11 * MiB;
constexpr size_t WS_NHAT = 11 * MiB + 64 * 1024;
constexpr size_t WS_NIN = 12 * MiB;
constexpr size_t WS_MIN = 12 * MiB + 512 * 1024;
constexpr size_t WS_WDT = 13 * MiB;
constexpr size_t WS_HB = 46 * MiB;
constexpr size_t WS_YB = 126 * MiB;
constexpr size_t WS_WGUT = 126 * MiB;
constexpr size_t WS_T = 191 * MiB;
constexpr size_t WS_WINT = 223 * MiB;
constexpr size_t WS_WOUTT = 229 * MiB;
constexpr size_t WS_XN = 231 * MiB;
constexpr size_t WS_MIXIN = 231 * MiB;
constexpr size_t WS_PROJ = 265 * MiB;
constexpr size_t WS_FCS = 333 * MiB;
constexpr size_t WS_QK = 365 * MiB;
constexpr size_t WS_CHAT = 399 * MiB;
constexpr size_t WS_CIN = 467 * MiB;
constexpr size_t WS_X1 = 446 * MiB;
constexpr size_t WS_MIXB = 265 * MiB;
constexpr size_t WS_END = 512 * MiB;
static_assert(WS_YB + (size_t)MAXTILES * 256 * 1024 * 2 <= WS_END, "YB");
static_assert(WS_CIN + (size_t)32 * 32 * 16384 * 2 <= WS_END, "CIN");
constexpr int CW_TMO = 0;
constexpr int CW_BAR = 4096;
constexpr int CW_CNT = 16384;
constexpr int CW_CNT2 = 24576;
constexpr int CW_MODDONE = 28672;
constexpr int CW_ADA = 20480;
constexpr int LDS_BYTES = 147456;
constexpr int LDS_ROWL = 131072;
constexpr int MOE1_SLOTS = 14;
constexpr int LDS_TB = 145408;
constexpr int LDS_MISC = 146432;

DI unsigned pk2(float lo, float hi) { unsigned r; asm("v_cvt_pk_bf16_f32 %0, %1, %2" : "=v"(r) : "v"(lo), "v"(hi)); return r; }
DI unsigned f2bf(float f) { return pk2(f, 0.f) & 0xffffu; }
typedef _Float16 f16x8 __attribute__((ext_vector_type(8)));
typedef _Float16 f16x2 __attribute__((ext_vector_type(2)));
DI unsigned pkh2(float lo, float hi) { const f16x2 h = (f16x2){(_Float16)lo, (_Float16)hi}; return __builtin_bit_cast(unsigned, h); }
DI float bf2f(unsigned b) { return __builtin_bit_cast(float, b << 16); }
DI float bflo(unsigned w) { return __builtin_bit_cast(float, w << 16); }
DI float bfhi(unsigned w) { return __builtin_bit_cast(float, w & 0xffff0000u); }
#define DPPF(x, ctrl) __builtin_bit_cast(float, __builtin_amdgcn_update_dpp(0, __builtin_bit_cast(int, (x)), (ctrl), 0xf, 0xf, false))
DI float red16(float v) { v += DPPF(v, 0xB1); v += DPPF(v, 0x4E); v += DPPF(v, 0x141); v += DPPF(v, 0x140); return v; }
DI float max16(float v) { v = fmaxf(v, DPPF(v, 0xB1)); v = fmaxf(v, DPPF(v, 0x4E)); v = fmaxf(v, DPPF(v, 0x141)); v = fmaxf(v, DPPF(v, 0x140)); return v; }
DI float rdl(float v, int l) { return __builtin_bit_cast(float, __builtin_amdgcn_readlane(__builtin_bit_cast(int, v), l)); }
DI float wave_sum(float v) { v = red16(v); return (rdl(v, 0) + rdl(v, 16)) + (rdl(v, 32) + rdl(v, 48)); }
DI float wave_max(float v) { v = max16(v); return fmaxf(fmaxf(rdl(v, 0), rdl(v, 16)), fmaxf(rdl(v, 32), rdl(v, 48))); }
DI int wave_min_i(int v) {
#pragma unroll
    for (int o = 1; o < 64; o <<= 1) { const int t = __shfl_xor(v, o); v = t < v ? t : v; }
    return v;
}
DI float scan_add(float x, int lane) {
#pragma unroll
    for (int o = 1; o < 64; o <<= 1) { const float t = __shfl_up(x, o); if (lane >= o) x += t; }
    return x;
}
DI float scan_max(float x, int lane) {
#pragma unroll
    for (int o = 1; o < 64; o <<= 1) { const float t = __shfl_up(x, o); if (lane >= o) x = fmaxf(x, t); }
    return x;
}
DI float siluf(float v) { return v * __builtin_amdgcn_rcpf(1.0f + __expf(-v)); }
DI float sigmf(float v) { return __builtin_amdgcn_rcpf(1.0f + __expf(-v)); }
DI float logsigf(float x) { return x >= 0.f ? -log1pf(expf(-x)) : x - log1pf(expf(x)); }
#define LDS_WAIT() asm volatile("s_waitcnt lgkmcnt(0)" ::: "memory")
#define VM_WAIT() asm volatile("s_waitcnt vmcnt(0)" ::: "memory")
#define MFMA16(a, b, c) __builtin_amdgcn_mfma_f32_16x16x32_bf16((a), (b), (c), 0, 0, 0)

DI unsigned lds_addr(const LAS void* p) { return (unsigned)(size_t)p; }
template <int ST, int KG> DI unsigned tr_base(unsigned tile, int lane) { return tile + (unsigned)((KG * (lane >> 4) + ((lane & 15) >> 2)) * ST + 8 * (lane & 3)); }
template <int O0, int O1> DI bf16x8 tr2(unsigned a) { u32x2 lo, hi;
    asm volatile("ds_read_b64_tr_b16 %0, %2 offset:%3\n\tds_read_b64_tr_b16 %1, %2 offset:%4\n\ts_waitcnt lgkmcnt(0)" : "=&v"(lo), "=&v"(hi) : "v"(a), "n"(O0), "n"(O1) : "memory");
    u32x4 r; r.x = lo.x; r.y = lo.y; r.z = hi.x; r.w = hi.y; return __builtin_bit_cast(bf16x8, r); }
template <int OB, int D2> DI void tr2x8(unsigned a, bf16x8 (&f)[8]) { u32x2 l0, l1, l2, l3, l4, l5, l6, l7, h0, h1, h2, h3, h4, h5, h6, h7;
    asm volatile("ds_read_b64_tr_b16 %0, %16 offset:%17\n\tds_read_b64_tr_b16 %1, %16 offset:%18\n\tds_read_b64_tr_b16 %2, %16 offset:%19\n\tds_read_b64_tr_b16 %3, %16 offset:%20\n\t"
                 "ds_read_b64_tr_b16 %4, %16 offset:%21\n\tds_read_b64_tr_b16 %5, %16 offset:%22\n\tds_read_b64_tr_b16 %6, %16 offset:%23\n\tds_read_b64_tr_b16 %7, %16 offset:%24\n\t"
                 "ds_read_b64_tr_b16 %8, %16 offset:%25\n\tds_read_b64_tr_b16 %9, %16 offset:%26\n\tds_read_b64_tr_b16 %10, %16 offset:%27\n\tds_read_b64_tr_b16 %11, %16 offset:%28\n\t"
                 "ds_read_b64_tr_b16 %12, %16 offset:%29\n\tds_read_b64_tr_b16 %13, %16 offset:%30\n\tds_read_b64_tr_b16 %14, %16 offset:%31\n\tds_read_b64_tr_b16 %15, %16 offset:%32\n\ts_waitcnt lgkmcnt(0)"
                 : "=&v"(l0), "=&v"(l1), "=&v"(l2), "=&v"(l3), "=&v"(l4), "=&v"(l5), "=&v"(l6), "=&v"(l7), "=&v"(h0), "=&v"(h1), "=&v"(h2), "=&v"(h3), "=&v"(h4), "=&v"(h5), "=&v"(h6), "=&v"(h7)
                 : "v"(a), "n"(OB), "n"(OB + 32), "n"(OB + 64), "n"(OB + 96), "n"(OB + 128), "n"(OB + 160), "n"(OB + 192), "n"(OB + 224),
                   "n"(OB + D2), "n"(OB + D2 + 32), "n"(OB + D2 + 64), "n"(OB + D2 + 96), "n"(OB + D2 + 128), "n"(OB + D2 + 160), "n"(OB + D2 + 192), "n"(OB + D2 + 224) : "memory");
#define TRP_(i, L, H) { u32x4 r; r.x = L.x; r.y = L.y; r.z = H.x; r.w = H.y; f[i] = __builtin_bit_cast(bf16x8, r); }
    TRP_(0, l0, h0) TRP_(1, l1, h1) TRP_(2, l2, h2) TRP_(3, l3, h3) TRP_(4, l4, h4) TRP_(5, l5, h5) TRP_(6, l6, h6) TRP_(7, l7, h7)
#undef TRP_
}

template <int OB, int D2> DI void tr2x4(unsigned a, bf16x8 (&f)[4]) { u32x2 l0, l1, l2, l3, h0, h1, h2, h3;
    asm volatile("ds_read_b64_tr_b16 %0, %8 offset:%9\n\tds_read_b64_tr_b16 %1, %8 offset:%10\n\tds_read_b64_tr_b16 %2, %8 offset:%11\n\tds_read_b64_tr_b16 %3, %8 offset:%12\n\t"
                 "ds_read_b64_tr_b16 %4, %8 offset:%13\n\tds_read_b64_tr_b16 %5, %8 offset:%14\n\tds_read_b64_tr_b16 %6, %8 offset:%15\n\tds_read_b64_tr_b16 %7, %8 offset:%16\n\ts_waitcnt lgkmcnt(0)"
                 : "=&v"(l0), "=&v"(l1), "=&v"(l2), "=&v"(l3), "=&v"(h0), "=&v"(h1), "=&v"(h2), "=&v"(h3)
                 : "v"(a), "n"(OB), "n"(OB + 32), "n"(OB + 64), "n"(OB + 96), "n"(OB + D2), "n"(OB + D2 + 32), "n"(OB + D2 + 64), "n"(OB + D2 + 96) : "memory");
#define TRP_(i, L, H) { u32x4 r; r.x = L.x; r.y = L.y; r.z = H.x; r.w = H.y; f[i] = __builtin_bit_cast(bf16x8, r); }
    TRP_(0, l0, h0) TRP_(1, l1, h1) TRP_(2, l2, h2) TRP_(3, l3, h3)
#undef TRP_
}

#define XB_TMO      128
#define XB_XCNT(j)  (256  + 64 * (j))
#define XB_XSUB(j)  (1280 + 64 * (j))
#define XB_XGEN(j)  (2304 + 64 * (j))
#define XB_TOP      3328
#define XB_TOPGEN   3392
#define XCD_BAR_WORDS 3456
#define XB_SPIN_CAP (1u << 18)
DI unsigned xb_ld(unsigned* p)              { return __hip_atomic_load(p, __ATOMIC_RELAXED, __HIP_MEMORY_SCOPE_AGENT); }
DI unsigned xb_add(unsigned* p, unsigned v) { return __hip_atomic_fetch_add(p, v, __ATOMIC_RELAXED, __HIP_MEMORY_SCOPE_AGENT); }
DI unsigned xb_xcc_id() { return (unsigned)__builtin_amdgcn_s_getreg((3 << 11) | 20) & 0xFu; }
#define XB_SPIN(cond, bar) do { unsigned _sp = 0; while (cond) { __builtin_amdgcn_s_sleep(1); \
    if ((++_sp & 255u) == 0u) { if (xb_ld(&(bar)[XB_TMO])) break; if (_sp > XB_SPIN_CAP) { atomicAdd(&(bar)[XB_TMO], 1u); break; } } } } while (0)
struct XcdBarrier { unsigned* bar; unsigned x; volatile LAS unsigned* st; };
DI XcdBarrier xcd_barrier_post(unsigned* bar, volatile LAS unsigned* st) {
    XcdBarrier b; b.bar = bar; b.x = xb_xcc_id(); b.st = st;
    if (threadIdx.x == 0) (void)xb_add(&bar[XB_XCNT(b.x)], 1u);
    return b;
}
DI void xcd_barrier_complete(unsigned* bar, unsigned x, unsigned& nloc, unsigned& nx) {
    const unsigned G = gridDim.x * gridDim.y * gridDim.z;
    unsigned sum, cnt, mine, sp = 0u;
    for (;;) {
        sum = 0u; cnt = 0u; mine = 0u;
#pragma unroll
        for (unsigned j = 0; j < 16; ++j) { const unsigned c = xb_ld(&bar[XB_XCNT(j)]); sum += c; cnt += (c > 0u) ? 1u : 0u; mine = (j == x) ? c : mine; }
        if (sum == G) break;
        __builtin_amdgcn_s_sleep(1);
        if ((++sp & 255u) == 0u) { if (xb_ld(&bar[XB_TMO])) break; if (sp > XB_SPIN_CAP) { atomicAdd(&bar[XB_TMO], 1u); break; } }
    }
    nloc = mine > 0u ? mine : 1u; nx = cnt > 0u ? cnt : 1u;
}
DI void xcd_barrier(const XcdBarrier& b) {
    asm volatile("s_waitcnt vmcnt(0)" ::: "memory");
    __syncthreads();
    if (threadIdx.x == 0) {
        unsigned* bar = b.bar;
        __builtin_amdgcn_s_waitcnt(0);
        unsigned nloc = b.st[0], nx = b.st[1];
        if (nloc == 0u) { xcd_barrier_complete(bar, b.x, nloc, nx); b.st[0] = nloc; b.st[1] = nx; }
        const unsigned old = xb_add(&bar[XB_XSUB(b.x)], 1u);
        const unsigned gen = old / nloc;
        if (old + 1u == (gen + 1u) * nloc) {
            __builtin_amdgcn_fence(__ATOMIC_RELEASE, "agent");
            asm volatile("s_waitcnt vmcnt(0)" ::: "memory");
            const unsigned og = xb_add(&bar[XB_TOP], 1u);
            const unsigned tg = og / nx;
            if (og + 1u == (tg + 1u) * nx) xb_add(&bar[XB_TOPGEN], 1u);
            else XB_SPIN(xb_ld(&bar[XB_TOPGEN]) == tg, bar);
            __builtin_amdgcn_fence(__ATOMIC_ACQUIRE, "agent");
            xb_add(&bar[XB_XGEN(b.x)], 1u);
            asm volatile("s_waitcnt vmcnt(0)" ::: "memory");
        } else {
            XB_SPIN(xb_ld(&bar[XB_XGEN(b.x)]) == gen, bar);
            __builtin_amdgcn_fence(__ATOMIC_ACQUIRE, "agent");
            asm volatile("s_waitcnt vmcnt(0)" ::: "memory");
        }
    }
    __syncthreads();
}

namespace pg8 {
constexpr int BM = 256, BK = 64, HALF = 128, HTB = HALF * BK * 2, STAGE_BYTES = 8 * HTB, NXCD = 8, WGM = 8;
__host__ __device__ __forceinline__ int lds_byte(int r, int c) { const int st = (r >> 4) * 2 + (c >> 5), rr = r & 15, cc = c & 31, ob = rr * 64 + cc * 2; return st * 1024 + (ob ^ (((ob >> 9) & 1) << 5)); }
__host__ __device__ __forceinline__ void stage_rc(int b, int& R, int& C) { const int st = b / 1024, sb = b % 1024, swz = sb ^ (((sb >> 9) & 1) << 5); R = (st >> 1) * 16 + swz / 64; C = (st & 1) * 32 + (swz % 64) / 2; }
__host__ __device__ __forceinline__ int perm32(int rho) { const int n = rho >> 4, i = rho & 15; return 8 * (i >> 2) + 4 * n + (i & 3); }
DI unsigned cvt_pk_bf16(float lo, float hi) { unsigned r; asm volatile("v_cvt_pk_bf16_f32 %0, %1, %2" : "=v"(r) : "v"(lo), "v"(hi)); return r; }
DI void static_tile(int L, int nM, int nN, int& pm, int& pn) {
    const int nwg = nM * nN; int wgid = L;
    { const int q = nwg / NXCD, r = nwg % NXCD, xcd = wgid % NXCD, off = wgid / NXCD; wgid = (xcd < r ? xcd * (q + 1) : r * (q + 1) + (xcd - r) * q) + off; }
    const int nig = WGM * nN, gid = wgid / nig, fm = gid * WGM, gsz = (nM - fm) < WGM ? (nM - fm) : WGM;
    pm = fm + ((wgid % nig) % gsz); pn = (wgid % nig) / gsz;
}
template <class Epi, class Sched, bool SP2 = false, bool ALIGN_EPI = false>
DI void gemm_phase(LAS unsigned char* lds, const char* Abase, const int K, const Sched& S, const Epi& E) {
    constexpr bool GA = Sched::GATHER;
    const int tid = threadIdx.x, wid = __builtin_amdgcn_readfirstlane(tid >> 6), lane = tid & 63, wr = wid >> 2, wc = wid & 3, fr = lane & 15, fq = lane >> 4;
    const int nt = K / BK;
    unsigned voffB[2], voffA[2]; int Rr[2], Cc[2];
#pragma unroll
    for (int i = 0; i < 2; ++i) { int R, C; stage_rc(tid * 16 + i * 8192, R, C); Rr[i] = R; Cc[i] = C; const int Rb = Epi::PERM ? ((R & ~31) + perm32(R & 31)) : R; voffB[i] = (unsigned)(Rb * K + C) * 2u; voffA[i] = (unsigned)(R * K + C) * 2u; }
    const size_t kstep = (size_t)(BK * 2);
    const size_t hstep = (size_t)HALF * K * 2;
    const unsigned ldsw = (unsigned)wid * 1024u;
    const int aoff = lds_byte(wr * 64 + fr, fq * 8), boff = lds_byte(wc * 32 + fr, fq * 8);
#define PG8_SA(b, h) (((b) * 2 + (h)) * HTB)
#define PG8_SB(b, h) ((4 + (b) * 2 + (h)) * HTB)
#define PG8_STAGE(bufoff, gbase, voff) do { _Pragma("unroll") for (int _i = 0; _i < 2; ++_i) \
        __builtin_amdgcn_global_load_lds((const unsigned*)((const char*)(gbase) + (voff)[_i]), (LAS unsigned*)(lds + (bufoff) + ldsw + _i * 8192), 16, 0, 0); } while (0)
#define PG8_STAGE_A(bufoff, ptr, h, OFFS) do { if constexpr (GA) { PG8_STAGE(bufoff, ptr, (OFFS)[h]); } else { PG8_STAGE(bufoff, (ptr) + (h) * hstep, voffA); } } while (0)
#define PG8_LDA(dst, b, h) do { _Pragma("unroll") for (int m = 0; m < 4; ++m) _Pragma("unroll") for (int k = 0; k < 2; ++k) dst[m][k] = *(const LAS bf16x8*)(lds + PG8_SA(b, h) + aoff + m * 2048 + k * 1024); } while (0)
#define PG8_LDB(dst, b, h) do { _Pragma("unroll") for (int n = 0; n < 2; ++n) _Pragma("unroll") for (int k = 0; k < 2; ++k) dst[n][k] = *(const LAS bf16x8*)(lds + PG8_SB(b, h) + boff + n * 2048 + k * 1024); } while (0)
#define PG8_MMA(ai, bj, At, Bt) do { __builtin_amdgcn_s_setprio(1); _Pragma("unroll") for (int m = 0; m < 4; ++m) _Pragma("unroll") for (int n = 0; n < 2; ++n) _Pragma("unroll") for (int k = 0; k < 2; ++k) \
        acc[ai][bj][m][n] = __builtin_amdgcn_mfma_f32_16x16x32_bf16(Bt[n][k], At[m][k], acc[ai][bj][m][n], 0, 0, 0); __builtin_amdgcn_s_setprio(0); } while (0)
#define PG8_WAIT_V(n) asm volatile("s_waitcnt vmcnt(" #n ")" ::: "memory")
#define PG8_WAIT_L(n) asm volatile("s_waitcnt lgkmcnt(" #n ")" ::: "memory")
#define PG8_BAR __builtin_amdgcn_s_barrier()
#define PG8_SCHED __builtin_amdgcn_sched_barrier(0)
    typename Sched::Unit cur, nxt; int ui = 0;
    if (!S.next(0, cur)) return;
    f32x4 acc[2][2][4][2];
#pragma unroll
    for (int a = 0; a < 2; ++a)
#pragma unroll
        for (int b = 0; b < 2; ++b)
#pragma unroll
            for (int m = 0; m < 4; ++m)
#pragma unroll
                for (int n = 0; n < 2; ++n) acc[a][b][m][n] = (f32x4){0.f, 0.f, 0.f, 0.f};
    bf16x8 At[4][2], B0[2][2], B1[2][2];
    unsigned cAo[2][2], nAo[2][2];
    const char* cA = Abase;
    if constexpr (GA) S.a_off(cur, Rr, Cc, cAo); else cA = S.a_ptr(cur);
    const char* cB = S.b_ptr(cur);
    if constexpr (SP2) {
        PG8_STAGE(PG8_SB(0, 0), cB, voffB); PG8_STAGE(PG8_SB(0, 1), cB + hstep, voffB); PG8_STAGE_A(PG8_SA(0, 0), cA, 0, cAo); PG8_STAGE_A(PG8_SA(0, 1), cA, 1, cAo);
        if (wr == 1) PG8_BAR;
        PG8_WAIT_V(2); PG8_BAR;
        PG8_STAGE(PG8_SB(1, 0), cB + kstep, voffB); PG8_STAGE_A(PG8_SA(1, 0), cA + kstep, 0, cAo); PG8_STAGE(PG8_SB(1, 1), cB + hstep + kstep, voffB);
        PG8_WAIT_V(6); PG8_BAR;
    } else {
        PG8_STAGE(PG8_SB(0, 0), cB, voffB); PG8_STAGE_A(PG8_SA(0, 0), cA, 0, cAo); PG8_STAGE(PG8_SB(0, 1), cB + hstep, voffB); PG8_STAGE_A(PG8_SA(0, 1), cA, 1, cAo);
        if (wr == 1) PG8_BAR;
        PG8_WAIT_V(4); PG8_BAR;
        PG8_STAGE(PG8_SB(1, 0), cB + kstep, voffB); PG8_STAGE_A(PG8_SA(1, 0), cA + kstep, 0, cAo); PG8_STAGE(PG8_SB(1, 1), cB + hstep + kstep, voffB);
        PG8_WAIT_V(6); PG8_BAR;
    }
    for (;;) {
        const bool has_next = S.next(ui + 1, nxt);
        const char* nB = cB; const char* nA = cA;
        if constexpr (GA) {
#pragma unroll
            for (int h = 0; h < 2; ++h)
#pragma unroll
                for (int i = 0; i < 2; ++i) nAo[h][i] = cAo[h][i];
        }
        if (has_next) { if constexpr (GA) S.a_off(nxt, Rr, Cc, nAo); else nA = S.a_ptr(nxt); nB = S.b_ptr(nxt); }
        for (int t = 0; t < nt; t += 2) {
            const bool last = (t == nt - 2);
            const char* a1 = cA + (size_t)(t + 1) * kstep;
            const char* a2 = last ? nA : cA + (size_t)(t + 2) * kstep; const char* b2 = last ? nB : cB + (size_t)(t + 2) * kstep;
            const char* a3 = a2 + kstep; const char* b3 = b2 + kstep;
            unsigned o2[2][2];
            if constexpr (GA) {
#pragma unroll
                for (int h = 0; h < 2; ++h)
#pragma unroll
                    for (int i = 0; i < 2; ++i) o2[h][i] = last ? nAo[h][i] : cAo[h][i];
            }
            if constexpr (SP2) {
            PG8_LDB(B0, 0, 0); PG8_LDB(B1, 0, 1); PG8_SCHED; PG8_LDA(At, 0, 0); PG8_STAGE_A(PG8_SA(1, 1), a1, 1, cAo);
            PG8_WAIT_V(8); PG8_WAIT_L(0); PG8_BAR; PG8_MMA(0, 0, At, B0); PG8_MMA(0, 1, At, B1); PG8_BAR; PG8_SCHED;
            PG8_LDA(At, 0, 1); PG8_STAGE(PG8_SB(0, 0), b2, voffB); PG8_STAGE(PG8_SB(0, 1), b2 + hstep, voffB); PG8_STAGE_A(PG8_SA(0, 0), a2, 0, o2);
            PG8_WAIT_V(8); PG8_WAIT_L(0); PG8_BAR; PG8_MMA(1, 0, At, B0); PG8_MMA(1, 1, At, B1); PG8_BAR; PG8_SCHED;
            PG8_LDB(B0, 1, 0); PG8_LDB(B1, 1, 1); PG8_SCHED; PG8_LDA(At, 1, 0); PG8_STAGE_A(PG8_SA(0, 1), a2, 1, o2);
            PG8_WAIT_V(8); PG8_WAIT_L(0); PG8_BAR; PG8_MMA(0, 0, At, B0); PG8_MMA(0, 1, At, B1); PG8_BAR; PG8_SCHED;
            PG8_LDA(At, 1, 1); PG8_STAGE(PG8_SB(1, 0), b3, voffB); PG8_STAGE(PG8_SB(1, 1), b3 + hstep, voffB); PG8_STAGE_A(PG8_SA(1, 0), a3, 0, o2);
            PG8_WAIT_V(8); PG8_WAIT_L(0); PG8_BAR; PG8_MMA(1, 0, At, B0); PG8_MMA(1, 1, At, B1); PG8_BAR; PG8_SCHED;
            } else {
            PG8_LDB(B0, 0, 0); PG8_SCHED; PG8_LDA(At, 0, 0); PG8_STAGE_A(PG8_SA(1, 1), a1, 1, cAo);
            PG8_WAIT_L(8); PG8_BAR; PG8_WAIT_L(0); PG8_MMA(0, 0, At, B0); PG8_BAR; PG8_SCHED;
            PG8_LDB(B1, 0, 1); PG8_STAGE(PG8_SB(0, 0), b2, voffB);
            PG8_BAR; PG8_WAIT_L(0); PG8_MMA(0, 1, At, B1); PG8_BAR;
            PG8_LDA(At, 0, 1); PG8_STAGE_A(PG8_SA(0, 0), a2, 0, o2);
            PG8_BAR; PG8_WAIT_L(0); PG8_MMA(1, 0, At, B0); PG8_BAR; PG8_SCHED;
            PG8_STAGE(PG8_SB(0, 1), b2 + hstep, voffB);
            PG8_WAIT_V(6); PG8_BAR; PG8_MMA(1, 1, At, B1); PG8_BAR;
            PG8_LDB(B0, 1, 0); PG8_SCHED; PG8_LDA(At, 1, 0); PG8_STAGE_A(PG8_SA(0, 1), a2, 1, o2);
            PG8_WAIT_L(8); PG8_BAR; PG8_WAIT_L(0); PG8_MMA(0, 0, At, B0); PG8_BAR; PG8_SCHED;
            PG8_LDB(B1, 1, 1); PG8_STAGE(PG8_SB(1, 0), b3, voffB);
            PG8_BAR; PG8_WAIT_L(0); PG8_MMA(0, 1, At, B1); PG8_BAR;
            PG8_LDA(At, 1, 1); PG8_STAGE_A(PG8_SA(1, 0), a3, 0, o2);
            PG8_BAR; PG8_WAIT_L(0); PG8_MMA(1, 0, At, B0); PG8_BAR; PG8_SCHED;
            PG8_STAGE(PG8_SB(1, 1), b3 + hstep, voffB);
            PG8_WAIT_V(6); PG8_BAR; PG8_MMA(1, 1, At, B1); PG8_BAR;
            }
        }
        if constexpr (ALIGN_EPI) { if (wr == 0) PG8_BAR; }
        E(acc, cur, wr, wc, fr, fq);
        if (!has_next) break;
#pragma unroll
        for (int a = 0; a < 2; ++a)
#pragma unroll
            for (int b = 0; b < 2; ++b)
#pragma unroll
                for (int m = 0; m < 4; ++m)
#pragma unroll
                    for (int n = 0; n < 2; ++n) acc[a][b][m][n] = (f32x4){0.f, 0.f, 0.f, 0.f};
        cur = nxt; cB = nB; cA = nA; ++ui;
        if constexpr (GA) {
#pragma unroll
            for (int h = 0; h < 2; ++h)
#pragma unroll
                for (int i = 0; i < 2; ++i) cAo[h][i] = nAo[h][i];
        }
        if constexpr (ALIGN_EPI) { if (wr == 1) PG8_BAR; }
    }
    PG8_WAIT_V(0);
    if constexpr (!ALIGN_EPI) { if (wr == 0) PG8_BAR; }
    PG8_BAR;
#undef PG8_SA
#undef PG8_SB
#undef PG8_STAGE
#undef PG8_STAGE_A
#undef PG8_LDA
#undef PG8_LDB
#undef PG8_MMA
#undef PG8_WAIT_V
#undef PG8_WAIT_L
#undef PG8_BAR
#undef PG8_SCHED
}
}

struct Args { const float* in[22]; float* out; unsigned char* ws; int ph_lo, ph_hi, li, pad; };
struct Ctx {
    LAS unsigned char* lds;
    int tid, lane, wave, G, bid, dry;
    const float *x, *c, *ctx, *c_ctx, *w_ada, *b_ada, *w_in, *conv_w, *conv_b, *gate_b, *head_g, *w_out, *ln1_g, *ln1_b, *w_router, *router_bias, *w_egu, *w_ed, *w_sgu, *w_sd, *ln2_g, *ln2_b;
    float* out; unsigned char* ws;
    DI float* MODP() const { return (float*)(ws + WS_MODP); }
    DI float* MOD() const { return (float*)(ws + WS_TAB + 131072); }
    DI bf16* W1() const { return (bf16*)(ws + WS_TAB); }
    DI bf16* W2() const { return (bf16*)(ws + WS_TAB + 32768); }
    DI bf16* W2I() const { return (bf16*)(ws + WS_TAB + 49152); }
    DI bf16* WRH() const { return (bf16*)(ws + WS_TAB + 262144); }
    DI bf16* WRL() const { return (bf16*)(ws + WS_TAB + 393216); }
    DI f32x2* TW() const { return (f32x2*)(ws + WS_TAB + 65536); }
    DI float* GL() const { return (float*)(ws + WS_GL); }
    DI int* ROWTAB() const { return (int*)(ws + WS_ROWTAB); }
    DI int* EIDX() const { return (int*)(ws + WS_EIDX); }
    DI int* EPOS() const { return (int*)(ws + WS_EPOS); }
    DI float* EGATE() const { return (float*)(ws + WS_EGATE); }
    DI float* SC() const { return (float*)(ws + WS_SC); }
    DI float* NHAT() const { return (float*)(ws + WS_NHAT); }
    DI float* NIN() const { return (float*)(ws + WS_NIN); }
    DI float* MINV() const { return (float*)(ws + WS_MIN); }
    DI bf16* WDT() const { return (bf16*)(ws + WS_WDT); }
    DI bf16* HB() const { return (bf16*)(ws + WS_HB); }
    DI bf16* YB() const { return (bf16*)(ws + WS_YB); }
    DI bf16* WGUT() const { return (bf16*)(ws + WS_WGUT); }
    DI bf16* T() const { return (bf16*)(ws + WS_T); }
    DI bf16* WINT() const { return (bf16*)(ws + WS_WINT); }
    DI bf16* WOUTT() const { return (bf16*)(ws + WS_WOUTT); }
    DI bf16* XN() const { return (bf16*)(ws + WS_XN); }
    DI bf16* MIXIN() const { return (bf16*)(ws + WS_MIXIN); }
    DI bf16* PROJ() const { return (bf16*)(ws + WS_PROJ); }
    DI bf16* FCS() const { return (bf16*)(ws + WS_FCS); }
    DI bf16* QK() const { return (bf16*)(ws + WS_QK); }
    DI bf16* CIN() const { return (bf16*)(ws + WS_CIN); }
    DI float* CHAT() const { return (float*)(ws + WS_CHAT); }
    DI bf16* X1() const { return (bf16*)(ws + WS_X1); }
    DI bf16* MIXB() const { return (bf16*)(ws + WS_MIXB); }
    DI unsigned* ctl() const { return (unsigned*)(ws + WS_CTL); }
};

DI void p0_router_item(const Ctx& F, int item, LAS float* scr) {
    const int kb = item >> 1, nb = item & 1, k0 = 64 * kb, lane = F.lane;
    float t[32];
#pragma unroll
    for (int i = 0; i < 32; ++i) t[i] = F.w_router[(size_t)(k0 + 2 * i + (lane >> 5)) * 64 + 32 * nb + (lane & 31)];
#pragma unroll
    for (int i = 0; i < 32; ++i) scr[(2 * i + (lane >> 5)) * 33 + (lane & 31)] = t[i];
    LDS_WAIT();
    const int c = lane & 7;
#pragma unroll
    for (int j = 0; j < 4; ++j) { const int n = (lane >> 3) + 8 * j; const LAS float* sp = scr + (8 * c) * 33 + n;
        u32x4 oh; oh.x = pkh2(sp[0 * 33], sp[1 * 33]); oh.y = pkh2(sp[2 * 33], sp[3 * 33]); oh.z = pkh2(sp[4 * 33], sp[5 * 33]); oh.w = pkh2(sp[6 * 33], sp[7 * 33]);
        *(u32x4*)(F.WRH() + (size_t)(32 * nb + n) * 1024 + k0 + 8 * c) = oh; }
    LDS_WAIT();
}
DI void p0_adaln_item(const Ctx& F, int item, LAS float* scr) {
    const int cg = item % 24, ks = item / 24, lane = F.lane, col = 256 * cg + 4 * lane;
    { const int k = 64 * ks + lane;
#pragma unroll
      for (int r = 0; r < 5; ++r) { const float v = r < 4 ? F.c[r * 1024 + k] : F.c_ctx[k]; scr[lane * 8 + r] = v / (1.0f + expf(-v)); } }
    LDS_WAIT();
    f32x4 acc[5];
#pragma unroll
    for (int r = 0; r < 5; ++r) acc[r] = (f32x4){0.f, 0.f, 0.f, 0.f};
    const float* wp = F.w_ada + (size_t)(64 * ks) * 6144 + col;
#pragma unroll 1
    for (int k0 = 0; k0 < 64; k0 += 32) {
        f32x4 wv[32];
#pragma unroll
        for (int i = 0; i < 32; ++i) wv[i] = __builtin_nontemporal_load((const f32x4*)(wp + (size_t)(k0 + i) * 6144));
#pragma unroll
        for (int i = 0; i < 32; ++i) { const f32x4 s0 = *(const LAS f32x4*)(scr + (k0 + i) * 8); const float s4 = scr[(k0 + i) * 8 + 4];
            acc[0] += wv[i] * s0.x; acc[1] += wv[i] * s0.y; acc[2] += wv[i] * s0.z; acc[3] += wv[i] * s0.w; acc[4] += wv[i] * s4; } }
#pragma unroll
    for (int r = 0; r < 5; ++r) { unsigned long long* p = (unsigned long long*)(F.MODP() + (size_t)(ks * 5 + r) * 6144 + col);
        const f32x2 lo2 = (f32x2){acc[r].x, acc[r].y}, hi2 = (f32x2){acc[r].z, acc[r].w};
        __hip_atomic_store(p, __builtin_bit_cast(unsigned long long, lo2), __ATOMIC_RELAXED, __HIP_MEMORY_SCOPE_AGENT);
        __hip_atomic_store(p + 1, __builtin_bit_cast(unsigned long long, hi2), __ATOMIC_RELAXED, __HIP_MEMORY_SCOPE_AGENT); }
    asm volatile("s_waitcnt vmcnt(0)" ::: "memory");
    unsigned old = 0u; if (lane == 0) old = __hip_atomic_fetch_add(F.ctl() + CW_ADA + 16 * cg, 1u, __ATOMIC_RELAXED, __HIP_MEMORY_SCOPE_AGENT);
    old = (unsigned)__builtin_amdgcn_readfirstlane((int)old);
    if (old == 15u) {
#pragma unroll 1
        for (int r = 0; r < 5; ++r) { unsigned long long pa[16], pb[16];
#pragma unroll
            for (int q = 0; q < 16; ++q) { const unsigned long long* p = (const unsigned long long*)(F.MODP() + (size_t)(q * 5 + r) * 6144 + col);
                pa[q] = __hip_atomic_load(p, __ATOMIC_RELAXED, __HIP_MEMORY_SCOPE_AGENT); pb[q] = __hip_atomic_load(p + 1, __ATOMIC_RELAXED, __HIP_MEMORY_SCOPE_AGENT); }
            f32x4 sum = *(const f32x4*)(F.b_ada + col);
#pragma unroll
            for (int q = 0; q < 16; ++q) { const f32x2 a = __builtin_bit_cast(f32x2, pa[q]), b = __builtin_bit_cast(f32x2, pb[q]); sum.x += a.x; sum.y += a.y; sum.z += b.x; sum.w += b.y; }
            unsigned long long* mp = (unsigned long long*)(F.MOD() + r * 6144 + col); const f32x2 lo2 = (f32x2){sum.x, sum.y}, hi2 = (f32x2){sum.z, sum.w};
            __hip_atomic_store(mp, __builtin_bit_cast(unsigned long long, lo2), __ATOMIC_RELAXED, __HIP_MEMORY_SCOPE_AGENT);
            __hip_atomic_store(mp + 1, __builtin_bit_cast(unsigned long long, hi2), __ATOMIC_RELAXED, __HIP_MEMORY_SCOPE_AGENT); }
        asm volatile("s_waitcnt vmcnt(0)" ::: "memory");
        if (lane == 0) __hip_atomic_fetch_add(F.ctl() + CW_MODDONE, 1u, __ATOMIC_RELAXED, __HIP_MEMORY_SCOPE_AGENT); }
    LDS_WAIT();
}
DI void p0_fold_item(const Ctx& F, int item, LAS float* scr) {
    const int g = item & 7, kb = item >> 3, lane = F.lane, k0 = 32 * kb;
    { float t[32];
#pragma unroll
      for (int i = 0; i < 32; ++i) t[i] = F.w_in[(size_t)(k0 + i) * DINP + 2064 + 64 * g + lane];
#pragma unroll
      for (int i = 0; i < 32; ++i) scr[i * 68 + lane] = t[i]; }
    LDS_WAIT();
    const bool isc = lane <= 32; const int jf = isc ? lane : lane - 32;
    float acc[32];
#pragma unroll
    for (int i = 0; i < 32; ++i) acc[i] = 0.f;
#pragma unroll 1
    for (int ch = 0; ch < 4; ++ch) {
        float tb[16];
#pragma unroll
        for (int c = 0; c < 16; ++c) { const float a = (float)((jf * (16 * ch + c)) & 63) * (1.0f / 64.0f); tb[c] = isc ? __builtin_amdgcn_cosf(a) : __builtin_amdgcn_sinf(a); }
#pragma unroll
        for (int i = 0; i < 32; ++i) {
#pragma unroll
            for (int c4 = 0; c4 < 4; ++c4) { const f32x4 xv = *(const LAS f32x4*)(scr + i * 68 + 16 * ch + 4 * c4);
                acc[i] += (xv.x * tb[4 * c4] + xv.y * tb[4 * c4 + 1]) + (xv.z * tb[4 * c4 + 2] + xv.w * tb[4 * c4 + 3]); }
            if ((i & 3) == 3) asm volatile("" ::: "memory"); }
    }
    bf16* dp = F.WINT() + (size_t)(2048 + 64 * g + lane) * 1024 + k0;
#pragma unroll
    for (int i8 = 0; i8 < 4; ++i8) { u32x4 o; o.x = pk2(acc[8 * i8], acc[8 * i8 + 1]); o.y = pk2(acc[8 * i8 + 2], acc[8 * i8 + 3]); o.z = pk2(acc[8 * i8 + 4], acc[8 * i8 + 5]); o.w = pk2(acc[8 * i8 + 6], acc[8 * i8 + 7]);
        *(u32x4*)(dp + 8 * i8) = o; }
    LDS_WAIT();
}
DI void p0_tables_item(const Ctx& F, int item) {
    const int idx = item * 64 + F.lane;
    if (idx < 16384) { const int m = idx >> 7, k = idx & 127, ri = m >> 6, k1 = m & 63, cs = k >> 6, n1 = k & 63;
        const float a = (float)((k1 * n1) & 63) * (1.0f / 64.0f), cv = __builtin_amdgcn_cosf(a), sv = __builtin_amdgcn_sinf(a);
        const float v = ri == 0 ? (cs == 0 ? cv : -sv) : (cs == 0 ? -sv : -cv); F.W1()[idx] = (bf16)f2bf(v); }
    else if (idx < 24576) { const int j = idx - 16384, k2 = j >> 7, k = j & 127, ri = k >> 6, n2 = k & 63;
        const float a = (float)((k2 * n2) & 63) * (1.0f / 64.0f), cv = __builtin_amdgcn_cosf(a), sv = __builtin_amdgcn_sinf(a);
        F.W2()[j] = (bf16)f2bf(ri == 0 ? cv : sv); F.W2I()[j] = (bf16)f2bf(ri == 0 ? -sv : cv); }
    else { const int j = idx - 24576; const float a = (float)j * (6.283185307179586f / 4096.0f); F.TW()[j] = (f32x2){cosf(a), sinf(a)}; }
}
struct TDesc { const float* src; bf16* dst; int ldw, K; };
constexpr int T_IN = 16 * 64, T_OUT = 16 * 32, T_GU = 65 * 256, T_DN = 65 * 128, T_ALL = T_IN + T_OUT + T_GU + T_DN;
constexpr int P2_BUSY = 664 - 512;
constexpr int T_LATE = (256 - P2_BUSY) * 8 * 10, T_EARLY = T_ALL - T_LATE;
DI void p0_tdesc(const Ctx& F, int r, int lane, TDesc& d) {
    const float* W; int ldw, col0, K, k0; bf16* dst;
    if (r < T_IN) { const int kb = r >> 6, nb = r & 63; W = F.w_in; ldw = DINP; col0 = 32 * nb; K = 1024; k0 = 64 * kb; dst = F.WINT() + (size_t)(32 * nb) * 1024; }
    else if (r < T_IN + T_OUT) { const int q = r - T_IN, kb = q >> 5, nb = q & 31; W = F.w_out; ldw = 1024; col0 = 32 * nb; K = 1024; k0 = 64 * kb; dst = F.WOUTT() + (size_t)(32 * nb) * 1024; }
    else if (r < T_IN + T_OUT + T_GU) { const int q0 = r - T_IN - T_OUT, e = q0 >> 8, q = q0 & 255, kb = q >> 4, nb = q & 15;
        W = e < 64 ? F.w_egu + (size_t)e * 1024 * 512 : F.w_sgu; ldw = 512; col0 = 32 * nb; K = 1024; k0 = 64 * kb;
        const int bj = col0 >> 8, hid = col0 & 255, drow = 256 * (hid >> 7) + 128 * bj + (hid & 127); dst = F.WGUT() + ((size_t)e * 512 + drow) * 1024; }
    else { const int q0 = r - T_IN - T_OUT - T_GU, e = q0 >> 7, q = q0 & 127, kb = q >> 5, nb = q & 31;
        W = e < 64 ? F.w_ed + (size_t)e * 256 * 1024 : F.w_sd; ldw = 1024; col0 = 32 * nb; K = 256; k0 = 64 * kb; dst = F.WDT() + ((size_t)e * 1024 + 32 * nb) * 256; }
    d.src = W + (size_t)(k0 + (lane >> 5)) * ldw + col0 + (lane & 31); d.dst = dst + k0; d.ldw = ldw; d.K = K;
}
DI void p0_tload(const TDesc& d, float (&t)[32]) {
#pragma unroll
    for (int i = 0; i < 32; ++i) t[i] = __builtin_nontemporal_load(d.src + (size_t)(2 * i) * d.ldw);
}
DI void p0_tstore(const TDesc& d, const float (&t)[32], LAS float* scr, int lane) {
#pragma unroll
    for (int i = 0; i < 32; ++i) scr[(2 * i + (lane >> 5)) * 33 + (lane & 31)] = t[i];
    LDS_WAIT();
    const int c = lane & 7;
#pragma unroll
    for (int j = 0; j < 4; ++j) { const int n = (lane >> 3) + 8 * j; const LAS float* s = scr + (8 * c) * 33 + n;
        u32x4 o; o.x = pk2(s[0 * 33], s[1 * 33]); o.y = pk2(s[2 * 33], s[3 * 33]); o.z = pk2(s[4 * 33], s[5 * 33]); o.w = pk2(s[6 * 33], s[7 * 33]);
        *(u32x4*)(d.dst + (size_t)n * d.K + 8 * c) = o; }
    LDS_WAIT();
}
DI void p0_transposes(const Ctx& F, LAS float* scr, int first, int stride, int end) {
    int it = first; TDesc dA, dB; float tA[32], tB[32];
    bool vA = it < end; if (vA) { p0_tdesc(F, it, F.lane, dA); p0_tload(dA, tA); }
    while (vA) {
        const int n1 = it + stride; const bool vB = n1 < end; if (vB) { p0_tdesc(F, n1, F.lane, dB); p0_tload(dB, tB); }
        p0_tstore(dA, tA, scr, F.lane);
        if (!vB) break;
        const int n2 = n1 + stride; vA = n2 < end; if (vA) { p0_tdesc(F, n2, F.lane, dA); p0_tload(dA, tA); }
        p0_tstore(dB, tB, scr, F.lane);
        it = n2;
    }
}
DI void p0_prologue(const Ctx& F) {
    LAS float* scr = (LAS float*)(F.lds + F.wave * 17408);
    const int gw = F.bid * 8 + F.wave, NGW = F.G * 8;
    constexpr int I_ADA = 384, I_FOLD = 256, I_TAB = 448, I_RT = 32, NSPEC = I_FOLD + I_ADA + I_TAB + I_RT;
    for (int it = gw; it < NSPEC; it += NGW) {
        int r = it;
        if (r < I_FOLD) { p0_fold_item(F, r, scr); continue; } r -= I_FOLD;
        if (r < I_ADA) { p0_adaln_item(F, r, scr); continue; } r -= I_ADA;
        if (r < I_TAB) { p0_tables_item(F, r); continue; } r -= I_TAB;
        p0_router_item(F, r, scr);
    }
    p0_transposes(F, scr, gw, NGW, (F.G == 256 && MK_N_LAUNCHES == 1) ? T_EARLY : T_ALL);
}

DI void p1_lnmod(const Ctx& F) {
    LAS float* modL = (LAS float*)F.lds;
    LAS bf16* tH = (LAS bf16*)(F.lds + 40960);
    LAS bf16* tLo = (LAS bf16*)(F.lds + 73984);
    LAS float* PL = (LAS float*)(F.lds + 107008);
    const int lane = F.lane, w = F.wave, tid = F.tid, fr = lane & 15, fq = lane >> 4;
    __syncthreads();
    bf16x8 wbh[4], wbl[4];
#pragma unroll
    for (int kk = 0; kk < 4; ++kk) { unsigned hi[8], lo[8];
#pragma unroll
        for (int j = 0; j < 8; ++j) { const float x = F.w_in[(size_t)(128 * w + 32 * kk + 8 * fq + j) * DINP + 2048 + fr]; hi[j] = f2bf(x); lo[j] = f2bf(x - bf2f(hi[j])); }
        u32x4 oh, ol; oh.x = hi[0] | (hi[1] << 16); oh.y = hi[2] | (hi[3] << 16); oh.z = hi[4] | (hi[5] << 16); oh.w = hi[6] | (hi[7] << 16);
        ol.x = lo[0] | (lo[1] << 16); ol.y = lo[2] | (lo[3] << 16); ol.z = lo[4] | (lo[5] << 16); ol.w = lo[6] | (lo[7] << 16);
        wbh[kk] = __builtin_bit_cast(bf16x8, oh); wbl[kk] = __builtin_bit_cast(bf16x8, ol); }
    if (MK_N_LAUNCHES == 1) {
        if (tid == 0) { unsigned sp = 0; while (__hip_atomic_load(F.ctl() + CW_MODDONE, __ATOMIC_RELAXED, __HIP_MEMORY_SCOPE_AGENT) < 24u && ++sp < (1u << 22)) __builtin_amdgcn_s_sleep(2); }
        __syncthreads(); }
    for (int i = tid; i < 5 * 2048; i += 512) modL[i] = __builtin_bit_cast(float, __hip_atomic_load((unsigned*)F.MOD() + (i >> 11) * 6144 + (i & 2047), __ATOMIC_RELAXED, __HIP_MEMORY_SCOPE_AGENT));
    __syncthreads();
    for (int g16 = F.bid; g16 < MALL / 16; g16 += F.G) {
        const int row0 = 16 * g16 + 2 * w;
        const int mr = row0 < MX ? (row0 >> 12) : 4;
        f32x4 xa[2][4];
#pragma unroll
        for (int rr = 0; rr < 2; ++rr) { const int row = row0 + rr; const float* xr = row < MX ? F.x + (size_t)row * 1024 : F.ctx + (size_t)(row - MX) * 1024;
#pragma unroll
            for (int m = 0; m < 4; ++m) xa[rr][m] = __builtin_nontemporal_load((const f32x4*)(xr + 256 * m + 4 * lane)); }
#pragma unroll
        for (int rr = 0; rr < 2; ++rr) {
            const int lr = 2 * w + rr, row = row0 + rr;
            f32x4 v[4]; float s = 0.f;
#pragma unroll
            for (int m = 0; m < 4; ++m) { v[m] = xa[rr][m]; s += (v[m].x + v[m].y) + (v[m].z + v[m].w); }
            const float mean = wave_sum(s) * (1.0f / 1024.0f); float s2 = 0.f;
#pragma unroll
            for (int m = 0; m < 4; ++m) { v[m] = v[m] - mean; s2 += (v[m].x * v[m].x + v[m].y * v[m].y) + (v[m].z * v[m].z + v[m].w * v[m].w); }
            const float rstd = 1.0f / sqrtf(wave_sum(s2) * (1.0f / 1024.0f) + LN_EPS);
            bf16* xo = F.XN() + (size_t)row * 1024;
#pragma unroll
            for (int m = 0; m < 4; ++m) { const int k = 256 * m + 4 * lane; const f32x4 sh = *(const LAS f32x4*)(modL + mr * 2048 + k), sc = *(const LAS f32x4*)(modL + mr * 2048 + 1024 + k);
                const f32x4 t = v[m] * rstd * (sc + 1.0f) + sh;
                u32x2 oh; oh.x = pk2(t.x, t.y); oh.y = pk2(t.z, t.w); *(u32x2*)(xo + k) = oh; *(LAS u32x2*)(tH + lr * 1032 + k) = oh;
                u32x2 ol; ol.x = pk2(t.x - bflo(oh.x), t.y - bfhi(oh.x)); ol.y = pk2(t.z - bflo(oh.y), t.w - bfhi(oh.y)); *(LAS u32x2*)(tLo + lr * 1032 + k) = ol; }
        }
        __syncthreads();
        {
            f32x4 a0 = (f32x4){0.f, 0.f, 0.f, 0.f}, a1 = a0, a2 = a0;
#pragma unroll
            for (int kk = 0; kk < 4; ++kk) { const bf16x8 ah = *(const LAS bf16x8*)(tH + fr * 1032 + 128 * w + 32 * kk + 8 * fq), al = *(const LAS bf16x8*)(tLo + fr * 1032 + 128 * w + 32 * kk + 8 * fq);
                a0 = MFMA16(ah, wbh[kk], a0); a1 = MFMA16(ah, wbl[kk], a1); a2 = MFMA16(al, wbh[kk], a2); }
#pragma unroll
            for (int r = 0; r < 4; ++r) PL[(w * 16 + 4 * fq + r) * 16 + fr] = a0[r] + (a1[r] + a2[r]);
        }
        __syncthreads();
        if (tid < 256) { const int lr = tid >> 4, g = tid & 15; float pre = F.gate_b[g];
#pragma unroll
            for (int ww = 0; ww < 8; ++ww) pre += PL[(ww * 16 + lr) * 16 + g];
            F.GL()[(size_t)(16 * g16 + lr) * 16 + g] = ((g >> 2) & 1) ? logsigf(pre) : pre; }
        __syncthreads();
    }
}

struct ProjOrder {
    struct Unit { int pm, pn; }; static constexpr bool GATHER = false;
    int G, c; const bf16* WinT; const bf16* A;
    DI bool next(int i, Unit& u) const { const int L = i * G + c; if (L >= 664) return false;
        if (L < 640) pg8::static_tile(L, 64, 10, u.pm, u.pn); else { const int j = L - 640; u.pm = 64 + j / 6; u.pn = j % 6; } return true; }
    DI const char* a_ptr(const Unit& u) const { return (const char*)(A + (size_t)u.pm * 256 * 1024); }
    DI const char* b_ptr(const Unit& u) const { return (const char*)(WinT + (size_t)u.pn * 256 * 1024); }
};
struct EpiProj {
    static constexpr bool PERM = true;
    bf16* PROJ; bf16* FCS;
    DI void operator()(const f32x4 (&acc)[2][2][4][2], const ProjOrder::Unit& u, int wr, int wc, int fr, int fq) const {
        const int row0 = u.pm * 256 + wr * 64 + fr;
        if (u.pn < 8) {
            const int col0 = u.pn * 256 + wc * 32 + 8 * fq;
#pragma unroll
            for (int ai = 0; ai < 2; ++ai)
#pragma unroll
                for (int m = 0; m < 4; ++m) { bf16* rowp = PROJ + (size_t)(row0 + ai * 128 + m * 16) * 2048 + col0;
#pragma unroll
                    for (int bj = 0; bj < 2; ++bj) { const f32x4 v0 = acc[ai][bj][m][0], v1 = acc[ai][bj][m][1];
                        u32x4 w; w.x = pg8::cvt_pk_bf16(v0[0], v0[1]); w.y = pg8::cvt_pk_bf16(v0[2], v0[3]); w.z = pg8::cvt_pk_bf16(v1[0], v1[1]); w.w = pg8::cvt_pk_bf16(v1[2], v1[3]);
                        *(u32x4*)(rowp + bj * 128) = w; } }
        } else {
            const int sc0 = (u.pn - 8) * 256 + wc * 32 + 8 * fq;
#pragma unroll
            for (int ai = 0; ai < 2; ++ai)
#pragma unroll
                for (int m = 0; m < 4; ++m) { const int row = row0 + ai * 128 + m * 16, b = row >> 12, n = row & 4095;
#pragma unroll
                    for (int bj = 0; bj < 2; ++bj) { const int sc = sc0 + bj * 128, g = sc >> 6, sl = sc & 63, part = sl >> 5, cb = 8 * g + ((sl & 31) >> 2); const f32x4 v0 = acc[ai][bj][m][0], v1 = acc[ai][bj][m][1];
                        bf16* p = FCS + ((size_t)((b * 2 + part) * 64 + cb) * 4096 + n) * 4;
                        u32x2 w0, w1; w0.x = pg8::cvt_pk_bf16(v0[0], v0[1]); w0.y = pg8::cvt_pk_bf16(v0[2], v0[3]); w1.x = pg8::cvt_pk_bf16(v1[0], v1[1]); w1.y = pg8::cvt_pk_bf16(v1[2], v1[3]);
                        *(u32x2*)p = w0; *(u32x2*)(p + (size_t)4096 * 4) = w1; } }
        }
    }
};

DI void conv_fma(float (&acc)[8], const float (&w)[8], const u32x4 v) {
    acc[0] += w[0] * bflo(v.x); acc[1] += w[1] * bfhi(v.x); acc[2] += w[2] * bflo(v.y); acc[3] += w[3] * bfhi(v.y);
    acc[4] += w[4] * bflo(v.z); acc[5] += w[5] * bfhi(v.z); acc[6] += w[6] * bflo(v.w); acc[7] += w[7] * bfhi(v.w); }
DI void p3_conv(const Ctx& F) {
    const int cg = F.tid & 127, sub = F.tid >> 7;
    float w[9][8], bias[8];
#pragma unroll
    for (int t = 0; t < 9; ++t) { const f32x4 a = *(const f32x4*)(F.conv_w + t * 1024 + 8 * cg), b = *(const f32x4*)(F.conv_w + t * 1024 + 8 * cg + 4);
        w[t][0] = a.x; w[t][1] = a.y; w[t][2] = a.z; w[t][3] = a.w; w[t][4] = b.x; w[t][5] = b.y; w[t][6] = b.z; w[t][7] = b.w; }
    { const f32x4 a = *(const f32x4*)(F.conv_b + 8 * cg), b = *(const f32x4*)(F.conv_b + 8 * cg + 4);
      bias[0] = a.x; bias[1] = a.y; bias[2] = a.z; bias[3] = a.w; bias[4] = b.x; bias[5] = b.y; bias[6] = b.z; bias[7] = b.w; }
    const float osc = cg >= 64 ? 0.08838834764831845f : 1.0f;
    const u32x4 zero = (u32x4){0u, 0u, 0u, 0u};
    for (int gi = F.bid; gi < NB * 64; gi += F.G) {
        const int gr = (F.G == 256) ? ((gi & 7) * 32 + (gi >> 3)) : gi;
        const int r = gr & 63, base = (gr >> 6) * 4096, c0 = 16 * sub;
        const bool up = r > 0, dn = r < 63;
        const bf16* pm = F.PROJ() + (size_t)(base + r * 64) * 2048 + 8 * cg;
        u32x4 L[3], M[3], Rt[3];
        if (c0 > 0) { L[0] = up ? *(const u32x4*)(pm + (long)(c0 - 1 - 64) * 2048) : zero; L[1] = *(const u32x4*)(pm + (long)(c0 - 1) * 2048); L[2] = dn ? *(const u32x4*)(pm + (long)(c0 - 1 + 64) * 2048) : zero; }
        else { L[0] = zero; L[1] = zero; L[2] = zero; }
        M[0] = up ? *(const u32x4*)(pm + (long)(c0 - 64) * 2048) : zero; M[1] = *(const u32x4*)(pm + (long)c0 * 2048); M[2] = dn ? *(const u32x4*)(pm + (long)(c0 + 64) * 2048) : zero;
#pragma unroll 2
        for (int i = 0; i < 16; ++i) { const int c = c0 + i;
            if (c < 63) { Rt[0] = up ? *(const u32x4*)(pm + (long)(c + 1 - 64) * 2048) : zero; Rt[1] = *(const u32x4*)(pm + (long)(c + 1) * 2048); Rt[2] = dn ? *(const u32x4*)(pm + (long)(c + 1 + 64) * 2048) : zero; }
            else { Rt[0] = zero; Rt[1] = zero; Rt[2] = zero; }
            float acc[8];
#pragma unroll
            for (int j = 0; j < 8; ++j) acc[j] = bias[j];
#pragma unroll
            for (int a = 0; a < 3; ++a) { conv_fma(acc, w[a * 3 + 0], L[a]); conv_fma(acc, w[a * 3 + 1], M[a]); conv_fma(acc, w[a * 3 + 2], Rt[a]); }
            u32x4 o; o.x = pk2(siluf(acc[0]) * osc, siluf(acc[1]) * osc); o.y = pk2(siluf(acc[2]) * osc, siluf(acc[3]) * osc);
            o.z = pk2(siluf(acc[4]) * osc, siluf(acc[5]) * osc); o.w = pk2(siluf(acc[6]) * osc, siluf(acc[7]) * osc);
            *(u32x4*)(F.QK() + (size_t)(base + r * 64 + c) * 1024 + 8 * cg) = o;
#pragma unroll
            for (int a = 0; a < 3; ++a) { L[a] = M[a]; M[a] = Rt[a]; } }
    }
    for (int it = F.bid * 4 + sub; it < MC; it += F.G * 4) {
        const int base = MX + (it & ~255), n = it & 255;
        float acc[8];
#pragma unroll
        for (int j = 0; j < 8; ++j) acc[j] = bias[j];
#pragma unroll
        for (int b = 0; b < 3; ++b) { const int nn = n + b - 1; if (nn >= 0 && nn < 256) conv_fma(acc, w[3 + b], *(const u32x4*)(F.PROJ() + (size_t)(base + nn) * 2048 + 8 * cg)); }
        u32x4 o; o.x = pk2(siluf(acc[0]) * osc, siluf(acc[1]) * osc); o.y = pk2(siluf(acc[2]) * osc, siluf(acc[3]) * osc);
        o.z = pk2(siluf(acc[4]) * osc, siluf(acc[5]) * osc); o.w = pk2(siluf(acc[6]) * osc, siluf(acc[7]) * osc);
        *(u32x4*)(F.QK() + (size_t)(MX + it) * 1024 + 8 * cg) = o;
    }
}

DI int chunk_row0(int b, int cc) { return cc < 2 ? MX + b * 256 + cc * 128 : b * 4096 + (cc - 2) * 128; }
constexpr int TS = 288;
DI void p4_item(const Ctx& F, int it) {
    const int seq = it / NCH, cc = it % NCH, dir = seq & 1, h = (seq >> 1) & 3, b = seq >> 3, R0 = chunk_row0(b, cc);
    LAS unsigned char* KW = F.lds;
    LAS unsigned char* VV = F.lds + 36864;
    LAS float* wS = (LAS float*)(F.lds + 73728);
    const int lane = F.lane, tid = F.tid;
    u32x4 kv[4], vv[4];
#pragma unroll
    for (int i = 0; i < 4; ++i) { const int idx = tid + 512 * i, row = idx >> 4, ch = idx & 15;
        kv[i] = *(const u32x4*)(F.QK() + (size_t)(R0 + row) * 1024 + 512 + h * 128 + 8 * ch); vv[i] = *(const u32x4*)(F.PROJ() + (size_t)(R0 + row) * 2048 + 1024 + h * 128 + 8 * ch); }
    if (F.wave == 0) {
        const int p0 = 2 * lane, p1 = p0 + 1, pos0 = dir ? 127 - p0 : p0, pos1 = dir ? 127 - p1 : p1;
        const float lf0 = F.GL()[(size_t)(R0 + pos0) * 16 + dir * 8 + 4 + h], lf1 = F.GL()[(size_t)(R0 + pos1) * 16 + dir * 8 + 4 + h];
        const float li0 = F.GL()[(size_t)(R0 + pos0) * 16 + dir * 8 + h], li1 = F.GL()[(size_t)(R0 + pos1) * 16 + dir * 8 + h];
        const float s = lf0 + lf1, incl = scan_add(s, lane), excl = incl - s, b0 = excl + lf0, b1 = b0 + lf1, a0 = li0 - b0, a1 = li1 - b1;
        const float A = wave_max(fmaxf(a0, a1)), total = __shfl(incl, 63);
        wS[pos0] = __expf(a0 - A); wS[pos1] = __expf(a1 - A);
        if (lane == 0) { F.SC()[it * 2] = A; F.SC()[it * 2 + 1] = total; }
    }
    __syncthreads();
#pragma unroll
    for (int i = 0; i < 4; ++i) { const int idx = tid + 512 * i, row = idx >> 4, ch = idx & 15; const float w = wS[row];
        u32x4 o; o.x = pk2(bflo(kv[i].x) * w, bfhi(kv[i].x) * w); o.y = pk2(bflo(kv[i].y) * w, bfhi(kv[i].y) * w); o.z = pk2(bflo(kv[i].z) * w, bfhi(kv[i].z) * w); o.w = pk2(bflo(kv[i].w) * w, bfhi(kv[i].w) * w);
        *(LAS u32x4*)(KW + row * TS + 16 * ch) = o; *(LAS u32x4*)(VV + row * TS + 16 * ch) = vv[i]; }
    __syncthreads();
    const int fr = lane & 15, fq = lane >> 4, w = F.wave;
    const unsigned ab = tr_base<TS, 8>(lds_addr(VV), lane) + 32u * (unsigned)w, bb = tr_base<TS, 8>(lds_addr(KW), lane);
    f32x4 acc[8], accn = (f32x4){0.f, 0.f, 0.f, 0.f};
#pragma unroll
    for (int nt = 0; nt < 8; ++nt) acc[nt] = (f32x4){0.f, 0.f, 0.f, 0.f};
    bf16x8 ones; { const u32x4 o1 = (u32x4){0x3f803f80u, 0x3f803f80u, 0x3f803f80u, 0x3f803f80u}; ones = __builtin_bit_cast(bf16x8, o1); }
#define P4_KK(kk) { const bf16x8 a = tr2<(kk) * 32 * TS, (kk) * 32 * TS + 4 * TS>(ab); bf16x8 bfr[8]; tr2x8<(kk) * 32 * TS, 4 * TS>(bb, bfr); \
        _Pragma("unroll") for (int nt = 0; nt < 8; ++nt) acc[nt] = MFMA16(a, bfr[nt], acc[nt]); \
        const bf16x8 bw = tr2<(kk) * 32 * TS, (kk) * 32 * TS + 4 * TS>(bb + 32u * (unsigned)w); accn = MFMA16(ones, bw, accn); }
    P4_KK(0) P4_KK(1) P4_KK(2) P4_KK(3)
#undef P4_KK
    float* co = F.CHAT() + (size_t)it * 16384;
#pragma unroll
    for (int nt = 0; nt < 8; ++nt)
#pragma unroll
        for (int r = 0; r < 4; ++r) co[(16 * w + 4 * fq + r) * 128 + 16 * nt + fr] = acc[nt][r];
    if (fq == 0) F.NHAT()[(size_t)it * 128 + 16 * w + fr] = accn[0];
    __syncthreads();
}

DI int proc_chunk(int dir, int p) { return dir == 0 ? p : (p < 2 ? 1 - p : 35 - p); }
DI void p5_scan(const Ctx& F) {
    LAS float* f1S = (LAS float*)F.lds;
    LAS float* f2S = f1S + 64;
    LAS int* itS = (LAS int*)(f1S + 128);
    for (int u = F.bid; u < 32 * 8; u += F.G) {
        const int seq = u >> 3, blk = u & 7, dir = seq & 1;
        if (F.tid == 0) { float m = 0.f;
            for (int p = 0; p < NCH; ++p) { const int it = seq * NCH + proc_chunk(dir, p); const float A = F.SC()[it * 2], bl = F.SC()[it * 2 + 1], Ml = fmaxf(m, A);
                f1S[p] = __expf(m - Ml); f2S[p] = __expf(A - Ml); itS[p] = it; if (blk == 0 && p >= 2) F.MINV()[seq * 32 + p - 2] = m; m = bl + Ml; } }
        __syncthreads();
        const int qd = blk * 512 + F.tid;
        f32x4 C = (f32x4){0.f, 0.f, 0.f, 0.f};
        { f32x4 ch[2];
#pragma unroll
          for (int q = 0; q < 2; ++q) ch[q] = *(const f32x4*)(F.CHAT() + (size_t)itS[q] * 16384 + qd * 4);
#pragma unroll
          for (int q = 0; q < 2; ++q) C = C * f1S[q] + ch[q] * f2S[q]; }
#pragma unroll 1
        for (int p0 = 2; p0 < NCH; p0 += 8) {
            f32x4 ch[8];
#pragma unroll
            for (int q = 0; q < 8; ++q) ch[q] = *(const f32x4*)(F.CHAT() + (size_t)itS[p0 + q] * 16384 + qd * 4);
#pragma unroll
            for (int q = 0; q < 8; ++q) { u32x2 o; o.x = pk2(C.x, C.y); o.y = pk2(C.z, C.w); *(u32x2*)(F.CIN() + ((size_t)(seq * 32 + p0 + q - 2) * 16384 + qd * 4)) = o;
                C = C * f1S[p0 + q] + ch[q] * f2S[p0 + q]; }
        }
        if (blk == 0 && F.tid < 128) { float n = 0.f;
#pragma unroll 1
            for (int p = 0; p < NCH; ++p) { if (p >= 2) F.NIN()[(size_t)(seq * 32 + p - 2) * 128 + F.tid] = n; n = n * f1S[p] + F.NHAT()[(size_t)itS[p] * 128 + F.tid] * f2S[p]; } }
        __syncthreads();
    }
}

DI void p6_mlstm_item(const Ctx& F, int it) {
    const int c = it & 31, h = (it >> 5) & 3, b = it >> 7, R0 = b * 4096 + c * 128;
    LAS unsigned char* Q = F.lds;
    LAS unsigned char* Kx = F.lds + 36864;
    LAS unsigned char* VV = F.lds + 73728;
    LAS float* aS = (LAS float*)(F.lds + 110592);
    LAS float* MS = aS + 256; LAS float* inS = aS + 512; LAS float* flS = aS + 768; LAS float* qnS = aS + 1024; LAS float* nS = aS + 1280;
    LAS float* OT = (LAS float*)F.lds;
    const int lane = F.lane, tid = F.tid, w = F.wave, fr = lane & 15, fq = lane >> 4;
    const int seq0 = (b * 4 + h) * 2, j0 = c, j1 = 31 - c;
    u32x4 lq[4], lk[4], lv[4];
#pragma unroll
    for (int i = 0; i < 4; ++i) { const int idx = tid + 512 * i, row = idx >> 4, ch = idx & 15;
        lq[i] = *(const u32x4*)(F.QK() + (size_t)(R0 + row) * 1024 + h * 128 + 8 * ch); lk[i] = *(const u32x4*)(F.QK() + (size_t)(R0 + row) * 1024 + 512 + h * 128 + 8 * ch);
        lv[i] = *(const u32x4*)(F.PROJ() + (size_t)(R0 + row) * 2048 + 1024 + h * 128 + 8 * ch); }
    if (w < 2) {
        const int dir = w, seq = seq0 + dir, j = dir ? j1 : j0; const float m_in = F.MINV()[seq * 32 + j];
        const int p0 = 2 * lane, p1 = p0 + 1, pos0 = dir ? 127 - p0 : p0, pos1 = dir ? 127 - p1 : p1;
        const float lf0 = F.GL()[(size_t)(R0 + pos0) * 16 + dir * 8 + 4 + h], lf1 = F.GL()[(size_t)(R0 + pos1) * 16 + dir * 8 + 4 + h];
        const float li0 = F.GL()[(size_t)(R0 + pos0) * 16 + dir * 8 + h], li1 = F.GL()[(size_t)(R0 + pos1) * 16 + dir * 8 + h];
        const float s = lf0 + lf1, incl = scan_add(s, lane), excl = incl - s, b0 = excl + lf0, b1 = b0 + lf1, a0 = li0 - b0, a1 = li1 - b1;
        const float c1 = fmaxf(a0, a1), pmi = scan_max(c1, lane); float pme = __shfl_up(pmi, 1); if (lane == 0) pme = -3.0e38f;
        const float M0 = fmaxf(m_in, fmaxf(pme, a0)), M1 = fmaxf(m_in, fmaxf(pme, c1));
        aS[dir * 128 + pos0] = a0; aS[dir * 128 + pos1] = a1; MS[dir * 128 + pos0] = M0; MS[dir * 128 + pos1] = M1;
        inS[dir * 128 + pos0] = __expf(m_in - M0); inS[dir * 128 + pos1] = __expf(m_in - M1);
        flS[dir * 128 + pos0] = __expf(-b0 - M0); flS[dir * 128 + pos1] = __expf(-b1 - M1);
        nS[dir * 128 + lane] = F.NIN()[(size_t)(seq * 32 + j) * 128 + lane]; nS[dir * 128 + 64 + lane] = F.NIN()[(size_t)(seq * 32 + j) * 128 + 64 + lane];
    }
#pragma unroll
    for (int i = 0; i < 4; ++i) { const int idx = tid + 512 * i, row = idx >> 4, ch = idx & 15;
        *(LAS u32x4*)(Q + row * TS + 16 * ch) = lq[i]; *(LAS u32x4*)(Kx + row * TS + 16 * ch) = lk[i]; *(LAS u32x4*)(VV + row * TS + 16 * ch) = lv[i]; }
    u32x4 lc0[4], lc1[4];
    { const bf16* C0 = F.CIN() + (size_t)(seq0 * 32 + j0) * 16384; const bf16* C1 = F.CIN() + (size_t)((seq0 + 1) * 32 + j1) * 16384;
#pragma unroll
      for (int i = 0; i < 4; ++i) { const int idx = tid + 512 * i; lc0[i] = *(const u32x4*)(C0 + idx * 8); lc1[i] = *(const u32x4*)(C1 + idx * 8); } }
    __syncthreads();
    if (tid < 256) { const int dir = tid >> 7, t = tid & 127; float s = 0.f;
#pragma unroll
        for (int j = 0; j < 16; ++j) { const u32x4 q = *(const LAS u32x4*)(Q + t * TS + 16 * j); const LAS float* np = nS + dir * 128 + 8 * j;
            s += bflo(q.x) * np[0] + bfhi(q.x) * np[1] + bflo(q.y) * np[2] + bfhi(q.y) * np[3] + bflo(q.z) * np[4] + bfhi(q.z) * np[5] + bflo(q.w) * np[6] + bfhi(q.w) * np[7]; }
        qnS[dir * 128 + t] = s; }
    bf16x8 qf[4];
#pragma unroll
    for (int kk = 0; kk < 4; ++kk) qf[kk] = *(const LAS bf16x8*)(Q + (16 * w + fr) * TS + 64 * kk + 16 * fq);
    const int tq = 16 * w + fr;
    bf16x8 sf0[4], sf1[4]; float rs0 = 0.f, rs1 = 0.f;
    {
        f32x4 sacc[8];
#pragma unroll
        for (int nt = 0; nt < 8; ++nt) sacc[nt] = (f32x4){0.f, 0.f, 0.f, 0.f};
#pragma unroll
        for (int kk = 0; kk < 4; ++kk)
#pragma unroll
            for (int nt = 0; nt < 8; ++nt) { const bf16x8 kf = *(const LAS bf16x8*)(Kx + (16 * nt + fr) * TS + 64 * kk + 16 * fq); sacc[nt] = MFMA16(kf, qf[kk], sacc[nt]); }
        const float Mt0 = MS[tq], Mt1 = MS[128 + tq];
#pragma unroll
        for (int kk = 0; kk < 4; ++kk) { float p0[8], p1[8];
#pragma unroll
            for (int hf = 0; hf < 2; ++hf) { const int nt = 2 * kk + hf; const f32x4 a40 = *(const LAS f32x4*)(aS + 16 * nt + 4 * fq), a41 = *(const LAS f32x4*)(aS + 128 + 16 * nt + 4 * fq);
#pragma unroll
                for (int r = 0; r < 4; ++r) { const int sk = 16 * nt + 4 * fq + r;
                    const float v0 = (sk <= tq) ? sacc[nt][r] * __expf(a40[r] - Mt0) : 0.f, v1 = (sk >= tq) ? sacc[nt][r] * __expf(a41[r] - Mt1) : 0.f;
                    rs0 += v0; rs1 += v1; p0[4 * hf + r] = v0; p1[4 * hf + r] = v1; } }
            u32x4 pk; pk.x = pk2(p0[0], p0[1]); pk.y = pk2(p0[2], p0[3]); pk.z = pk2(p0[4], p0[5]); pk.w = pk2(p0[6], p0[7]); sf0[kk] = __builtin_bit_cast(bf16x8, pk);
            pk.x = pk2(p1[0], p1[1]); pk.y = pk2(p1[2], p1[3]); pk.z = pk2(p1[4], p1[5]); pk.w = pk2(p1[6], p1[7]); sf1[kk] = __builtin_bit_cast(bf16x8, pk); }
    }
    rs0 += __shfl_xor(rs0, 16); rs0 += __shfl_xor(rs0, 32); rs1 += __shfl_xor(rs1, 16); rs1 += __shfl_xor(rs1, 32);
    __syncthreads();
#pragma unroll
    for (int i = 0; i < 4; ++i) { const int idx = tid + 512 * i, row = idx >> 4, ch = idx & 15; *(LAS u32x4*)(Kx + row * TS + 16 * ch) = lc0[i]; *(LAS u32x4*)(Q + row * TS + 16 * ch) = lc1[i]; }
    u32x4 og[4];
#pragma unroll
    for (int i = 0; i < 4; ++i) { const int cidx = lane + 64 * i; og[i] = *(const u32x4*)(F.PROJ() + (size_t)(R0 + 16 * w + (cidx >> 4)) * 2048 + 1536 + h * 128 + 8 * (cidx & 15)); }
    __syncthreads();
    const unsigned vb = tr_base<TS, 4>(lds_addr(VV), lane);
    f32x4 hs[8];
#pragma unroll
    for (int nt = 0; nt < 8; ++nt) hs[nt] = (f32x4){0.f, 0.f, 0.f, 0.f};
#define P6_HALF(hv, sf, CT) { f32x4 num[4]; \
        _Pragma("unroll") for (int q4 = 0; q4 < 4; ++q4) num[q4] = (f32x4){0.f, 0.f, 0.f, 0.f}; \
        { bf16x8 vf[4]; tr2x4<0 * 32 * TS + 128 * (hv), 16 * TS>(vb, vf); _Pragma("unroll") for (int q4 = 0; q4 < 4; ++q4) num[q4] = MFMA16(sf[0], vf[q4], num[q4]); } \
        { bf16x8 vf[4]; tr2x4<1 * 32 * TS + 128 * (hv), 16 * TS>(vb, vf); _Pragma("unroll") for (int q4 = 0; q4 < 4; ++q4) num[q4] = MFMA16(sf[1], vf[q4], num[q4]); } \
        { bf16x8 vf[4]; tr2x4<2 * 32 * TS + 128 * (hv), 16 * TS>(vb, vf); _Pragma("unroll") for (int q4 = 0; q4 < 4; ++q4) num[q4] = MFMA16(sf[2], vf[q4], num[q4]); } \
        { bf16x8 vf[4]; tr2x4<3 * 32 * TS + 128 * (hv), 16 * TS>(vb, vf); _Pragma("unroll") for (int q4 = 0; q4 < 4; ++q4) num[q4] = MFMA16(sf[3], vf[q4], num[q4]); } \
        _Pragma("unroll") for (int q4 = 0; q4 < 4; ++q4) _Pragma("unroll") for (int r = 0; r < 4; ++r) hs[4 * (hv) + q4][r] += num[q4][r] * inv[r]; \
        _Pragma("unroll") for (int q4 = 0; q4 < 4; ++q4) num[q4] = (f32x4){0.f, 0.f, 0.f, 0.f}; \
        _Pragma("unroll") for (int kk = 0; kk < 4; ++kk) _Pragma("unroll") for (int q4 = 0; q4 < 4; ++q4) { \
            const bf16x8 cf = *(const LAS bf16x8*)((CT) + (16 * (4 * (hv) + q4) + fr) * TS + 64 * kk + 16 * fq); num[q4] = MFMA16(qf[kk], cf, num[q4]); } \
        _Pragma("unroll") for (int q4 = 0; q4 < 4; ++q4) _Pragma("unroll") for (int r = 0; r < 4; ++r) hs[4 * (hv) + q4][r] += num[q4][r] * inter[r]; \
        asm volatile("" ::: "memory"); }
    {   float inter[4], inv[4];
#pragma unroll
        for (int r = 0; r < 4; ++r) { const int t = 16 * w + 4 * fq + r; const float rsr = __shfl(rs0, 4 * fq + r); inter[r] = inS[t];
            const float den = rsr + inter[r] * qnS[t]; inv[r] = 1.0f / fmaxf(fabsf(den), flS[t]); inter[r] *= inv[r]; }
        P6_HALF(0, sf0, Kx) P6_HALF(1, sf0, Kx) }
    {   float inter[4], inv[4];
#pragma unroll
        for (int r = 0; r < 4; ++r) { const int t = 16 * w + 4 * fq + r; const float rsr = __shfl(rs1, 4 * fq + r); inter[r] = inS[128 + t];
            const float den = rsr + inter[r] * qnS[128 + t]; inv[r] = 1.0f / fmaxf(fabsf(den), flS[128 + t]); inter[r] *= inv[r]; }
        P6_HALF(0, sf1, Q) P6_HALF(1, sf1, Q) }
#undef P6_HALF
    __syncthreads();
#pragma unroll
    for (int r = 0; r < 4; ++r) { const int t = 16 * w + 4 * fq + r; float s = 0.f;
#pragma unroll
        for (int nt = 0; nt < 8; ++nt) s += hs[nt][r];
        const float mean = red16(s) * (1.0f / 128.0f); float q2 = 0.f;
#pragma unroll
        for (int nt = 0; nt < 8; ++nt) { const float d = hs[nt][r] - mean; q2 += d * d; }
        const float rstd = 1.0f / sqrtf(red16(q2) * (1.0f / 128.0f) + LN_EPS);
#pragma unroll
        for (int nt = 0; nt < 8; ++nt) OT[t * 132 + 16 * nt + fr] = (hs[nt][r] - mean) * rstd; }
    LDS_WAIT();
#pragma unroll
    for (int i = 0; i < 4; ++i) { const int cidx = lane + 64 * i, t = 16 * w + (cidx >> 4), v0 = 8 * (cidx & 15);
        const f32x4 x0 = *(const LAS f32x4*)(OT + t * 132 + v0), x1 = *(const LAS f32x4*)(OT + t * 132 + v0 + 4);
        const f32x4 g0 = *(const f32x4*)(F.head_g + h * 128 + v0), g1 = *(const f32x4*)(F.head_g + h * 128 + v0 + 4);
        u32x4 o; o.x = pk2(x0.x * g0.x * sigmf(bflo(og[i].x)), x0.y * g0.y * sigmf(bfhi(og[i].x))); o.y = pk2(x0.z * g0.z * sigmf(bflo(og[i].y)), x0.w * g0.w * sigmf(bfhi(og[i].y)));
        o.z = pk2(x1.x * g1.x * sigmf(bflo(og[i].z)), x1.y * g1.y * sigmf(bfhi(og[i].z))); o.w = pk2(x1.z * g1.z * sigmf(bflo(og[i].w)), x1.w * g1.w * sigmf(bfhi(og[i].w)));
        *(u32x4*)(F.MIXIN() + (size_t)(R0 + t) * 1024 + h * 128 + v0) = o; }
    __syncthreads();
}

constexpr int FS_ = 544;
DI void p6_fourier_item(const Ctx& F, int it) {
    const int xs = it & 7, ss = it >> 3, pair = (ss >> 3) * 8 + xs, a8 = ss & 7, b = pair >> 3, g = pair & 7, cb = 8 * g + a8;
    const int tid = F.tid, lane = F.lane, w = F.wave, fr = lane & 15, fq = lane >> 4;
    LAS unsigned char* XL = F.lds;
    LAS unsigned char* YL = F.lds + 69632;
    LAS float* SR = (LAS float*)F.lds;
    LAS float* SI = SR + 4096;
#pragma unroll
    for (int i = 0; i < 8; ++i) { const int idx = tid + 512 * i, part = idx >> 11, wi = idx & 2047;
        *(LAS u32x4*)(XL + (part * 64 + (wi >> 5)) * FS_ + 16 * (wi & 31)) = *(const u32x4*)(F.FCS() + (size_t)((b * 2 + part) * 64 + cb) * 16384 + wi * 8); }
    __syncthreads();
    {
        const int pr = w & 3, nh = w >> 2;
        bf16x8 a0[4], a1[4];
#pragma unroll
        for (int kk = 0; kk < 4; ++kk) { a0[kk] = *(const bf16x8*)(F.W1() + (16 * pr + fr) * 128 + 32 * kk + 8 * fq); a1[kk] = *(const bf16x8*)(F.W1() + (16 * (pr + 4) + fr) * 128 + 32 * kk + 8 * fq); }
#pragma unroll 1
        for (int hv = 0; hv < 2; ++hv) {
            const unsigned xb = tr_base<FS_, 8>(lds_addr(XL), lane) + 256u * (unsigned)nh + 128u * (unsigned)hv;
            f32x4 yr[4], yi[4];
#pragma unroll
            for (int q4 = 0; q4 < 4; ++q4) { yr[q4] = (f32x4){0.f, 0.f, 0.f, 0.f}; yi[q4] = (f32x4){0.f, 0.f, 0.f, 0.f}; }
#define FT1_KK(kk) { bf16x8 bx[4]; tr2x4<(kk) * 32 * FS_, 4 * FS_>(xb, bx); _Pragma("unroll") for (int q4 = 0; q4 < 4; ++q4) { yr[q4] = MFMA16(a0[kk], bx[q4], yr[q4]); yi[q4] = MFMA16(a1[kk], bx[q4], yi[q4]); } }
            FT1_KK(0) FT1_KK(1) FT1_KK(2) FT1_KK(3)
#undef FT1_KK
#pragma unroll
            for (int q4 = 0; q4 < 4; ++q4) { const int nt = 8 * nh + 4 * hv + q4, n = 16 * nt + fr, n2 = n >> 2, col = n & 3;
#pragma unroll
                for (int r = 0; r < 4; ++r) { const int k1 = 16 * pr + 4 * fq + r; const float ang = (float)((k1 * n2) & 4095) * (1.0f / 4096.0f); const float twx = __builtin_amdgcn_cosf(ang), twy = __builtin_amdgcn_sinf(ang);
                    const float y2r = yr[q4][r] * twx + yi[q4][r] * twy, y2i = yi[q4][r] * twx - yr[q4][r] * twy;
                    *(LAS bf16*)(YL + (0 * 64 + n2) * FS_ + (k1 * 4 + col) * 2) = (bf16)f2bf(y2r); *(LAS bf16*)(YL + (1 * 64 + n2) * FS_ + (k1 * 4 + col) * 2) = (bf16)f2bf(y2i); } }
        }
    }
    __syncthreads();
    {
        const int mt = w & 3, nh = w >> 2;
        bf16x8 ar[4], ai[4];
#pragma unroll
        for (int kk = 0; kk < 4; ++kk) { ar[kk] = *(const bf16x8*)(F.W2() + (16 * mt + fr) * 128 + 32 * kk + 8 * fq); ai[kk] = *(const bf16x8*)(F.W2I() + (16 * mt + fr) * 128 + 32 * kk + 8 * fq); }
        bf16* orow0 = F.MIXIN() + (size_t)(b * 4096) * 1024 + 512 + 64 * g;
#pragma unroll 1
        for (int hv = 0; hv < 2; ++hv) {
            const unsigned yb = tr_base<FS_, 8>(lds_addr(YL), lane) + 256u * (unsigned)nh + 128u * (unsigned)hv;
            f32x4 xr[4], xi[4];
#pragma unroll
            for (int q4 = 0; q4 < 4; ++q4) { xr[q4] = (f32x4){0.f, 0.f, 0.f, 0.f}; xi[q4] = (f32x4){0.f, 0.f, 0.f, 0.f}; }
#define FT2_KK(kk) { bf16x8 by[4]; tr2x4<(kk) * 32 * FS_, 4 * FS_>(yb, by); _Pragma("unroll") for (int q4 = 0; q4 < 4; ++q4) { xr[q4] = MFMA16(ar[kk], by[q4], xr[q4]); if (a8 == 0) xi[q4] = MFMA16(ai[kk], by[q4], xi[q4]); } }
            FT2_KK(0) FT2_KK(1) FT2_KK(2) FT2_KK(3)
#undef FT2_KK
#pragma unroll
            for (int q4 = 0; q4 < 4; ++q4) { const int nt = 8 * nh + 4 * hv + q4, n = 16 * nt + fr, k1 = n >> 2, col = n & 3, j = 4 * a8 + col;
#pragma unroll
                for (int r = 0; r < 4; ++r) { const int k2 = 16 * mt + 4 * fq + r, k = k1 + 64 * k2;
                    if (j == 0) { SR[k] = xr[q4][r]; SI[k] = xi[q4][r]; }
                    else { const bf16 ov = (bf16)f2bf(xr[q4][r] * (1.0f / 512.0f)); orow0[(size_t)k * 1024 + j] = ov; orow0[(size_t)((4096 - k) & 4095) * 1024 + 64 - j] = ov; } } }
        }
    }
    __syncthreads();
    if (a8 == 0) {
        bf16* orow0 = F.MIXIN() + (size_t)(b * 4096) * 1024 + 512 + 64 * g;
#pragma unroll
        for (int i = 0; i < 8; ++i) { const int k = tid + 512 * i, km = (4096 - k) & 4095;
            orow0[(size_t)k * 1024] = (bf16)f2bf((SR[k] + SR[km]) * (0.5f / 512.0f)); orow0[(size_t)k * 1024 + 32] = (bf16)f2bf((SI[k] + SI[km]) * (-0.5f / 512.0f)); }
        __syncthreads();
    }
}

struct OutOrder {
    struct Unit { int pm, pn; }; static constexpr bool GATHER = false;
    int G, c; const bf16* Bt; const bf16* A;
    DI bool next(int i, Unit& u) const { const int L = i * G + c; if (L >= 256) return false; pg8::static_tile(L, 64, 4, u.pm, u.pn); return true; }
    DI const char* a_ptr(const Unit& u) const { return (const char*)(A + (size_t)u.pm * 256 * 1024); }
    DI const char* b_ptr(const Unit& u) const { return (const char*)(Bt + (size_t)u.pn * 256 * 1024); }
};
struct EpiMix {
    static constexpr bool PERM = true;
    bf16* Cm;
    DI void operator()(const f32x4 (&acc)[2][2][4][2], const OutOrder::Unit& u, int wr, int wc, int fr, int fq) const {
        const int row0 = u.pm * 256 + wr * 64 + fr, col0 = u.pn * 256 + wc * 32 + 8 * fq;
#pragma unroll
        for (int ai = 0; ai < 2; ++ai)
#pragma unroll
            for (int m = 0; m < 4; ++m) { bf16* rowp = Cm + (size_t)(row0 + ai * 128 + m * 16) * 1024 + col0;
#pragma unroll
                for (int bj = 0; bj < 2; ++bj) { const f32x4 v0 = acc[ai][bj][m][0], v1 = acc[ai][bj][m][1];
                    u32x4 w; w.x = pg8::cvt_pk_bf16(v0[0], v0[1]); w.y = pg8::cvt_pk_bf16(v0[2], v0[3]); w.z = pg8::cvt_pk_bf16(v1[0], v1[1]); w.w = pg8::cvt_pk_bf16(v1[2], v1[3]);
                    *(u32x4*)(rowp + bj * 128) = w; } }
    }
};

DI void p8_rows(const Ctx& F) {
    LAS float* modL = (LAS float*)F.lds;
    LAS bf16* tH = (LAS bf16*)(F.lds + 49152);
    LAS float* PL = (LAS float*)(F.lds + 115200);
    LAS int* lcnt = (LAS int*)(F.lds + 123392);
    LAS int* lbase = (LAS int*)(F.lds + 123648);
    LAS int* selP = (LAS int*)(F.lds + 123904);
    LAS float* selG = (LAS float*)(F.lds + 132096);
    const int lane = F.lane, w = F.wave, tid = F.tid, fr = lane & 15, fq = lane >> 4;
    const int nt = w & 3, kh = w >> 2;
    for (int i = tid; i < 4 * 3072; i += 512) modL[i] = F.MOD()[(i / 3072) * 6144 + 2048 + (i % 3072)];
    f16x8 wbh[16];
#pragma unroll
    for (int kk = 0; kk < 16; ++kk) wbh[kk] = *(const f16x8*)(F.WRH() + (size_t)(16 * nt + fr) * 1024 + 512 * kh + 32 * kk + 8 * fq);
    const float rbias = F.router_bias[lane];
    if (tid < 64) lcnt[tid] = 0;
    __syncthreads();
    int gi = 0;
    f32x4 xa[2][4]; u32x2 ma[2][4];
#define P8_LOAD(g16_) { const int r0_ = 16 * (g16_) + 2 * w; _Pragma("unroll") for (int rr = 0; rr < 2; ++rr) _Pragma("unroll") for (int m = 0; m < 4; ++m) { \
        xa[rr][m] = __builtin_nontemporal_load((const f32x4*)(F.x + (size_t)(r0_ + rr) * 1024 + 256 * m + 4 * lane)); ma[rr][m] = *(const u32x2*)(F.MIXB() + (size_t)(r0_ + rr) * 1024 + 256 * m + 4 * lane); } }
    if (F.bid < MX / 16) P8_LOAD(F.bid)
    for (int g16 = F.bid; g16 < MX / 16; g16 += F.G, ++gi) {
        const int b = (16 * g16) >> 12; const LAS float* md = modL + b * 3072;
        const int row0 = 16 * g16 + 2 * w;
#pragma unroll
        for (int rr = 0; rr < 2; ++rr) {
            const int lr = 2 * w + rr, row = row0 + rr;
            f32x4 v[4]; float s = 0.f;
#pragma unroll
            for (int m = 0; m < 4; ++m) { const f32x4 gt = *(const LAS f32x4*)(md + 256 * m + 4 * lane); const f32x4 mv = (f32x4){bflo(ma[rr][m].x), bfhi(ma[rr][m].x), bflo(ma[rr][m].y), bfhi(ma[rr][m].y)};
                v[m] = xa[rr][m] * ALPHA + gt * mv; s += (v[m].x + v[m].y) + (v[m].z + v[m].w); }
            float mean = wave_sum(s) * (1.0f / 1024.0f), s2 = 0.f;
#pragma unroll
            for (int m = 0; m < 4; ++m) { v[m] = v[m] - mean; s2 += (v[m].x * v[m].x + v[m].y * v[m].y) + (v[m].z * v[m].z + v[m].w * v[m].w); }
            float rstd = 1.0f / sqrtf(wave_sum(s2) * (1.0f / 1024.0f) + LN_EPS);
            s = 0.f;
#pragma unroll
            for (int m = 0; m < 4; ++m) { const int k = 256 * m + 4 * lane; const f32x4 gg = *(const f32x4*)(F.ln1_g + k), bb = *(const f32x4*)(F.ln1_b + k);
                v[m] = v[m] * rstd * gg + bb; u32x2 xo; xo.x = pk2(v[m].x, v[m].y); xo.y = pk2(v[m].z, v[m].w); *(u32x2*)(F.X1() + (size_t)row * 1024 + k) = xo; s += (v[m].x + v[m].y) + (v[m].z + v[m].w); }
            mean = wave_sum(s) * (1.0f / 1024.0f); s2 = 0.f;
#pragma unroll
            for (int m = 0; m < 4; ++m) { v[m] = v[m] - mean; s2 += (v[m].x * v[m].x + v[m].y * v[m].y) + (v[m].z * v[m].z + v[m].w * v[m].w); }
            rstd = 1.0f / sqrtf(wave_sum(s2) * (1.0f / 1024.0f) + LN_EPS);
            bf16* trow = F.T() + (size_t)row * 1024;
#pragma unroll
            for (int m = 0; m < 4; ++m) { const int k = 256 * m + 4 * lane; const f32x4 sh = *(const LAS f32x4*)(md + 1024 + k), sc = *(const LAS f32x4*)(md + 2048 + k);
                const f32x4 t = v[m] * rstd * (sc + 1.0f) + sh;
                u32x2 oh; oh.x = pk2(t.x, t.y); oh.y = pk2(t.z, t.w); *(u32x2*)(trow + k) = oh;
                u32x2 of; of.x = pkh2(t.x, t.y); of.y = pkh2(t.z, t.w); *(LAS u32x2*)(tH + lr * 1032 + k) = of; }
        }
        if (g16 + F.G < MX / 16) P8_LOAD(g16 + F.G)
        __syncthreads();
        {
            f32x4 a0 = (f32x4){0.f, 0.f, 0.f, 0.f}, a2 = a0;
#pragma unroll
            for (int kk = 0; kk < 16; kk += 2) { const f16x8 h0 = *(const LAS f16x8*)(tH + fr * 1032 + 512 * kh + 32 * kk + 8 * fq), h1 = *(const LAS f16x8*)(tH + fr * 1032 + 512 * kh + 32 * (kk + 1) + 8 * fq);
                a0 = __builtin_amdgcn_mfma_f32_16x16x32_f16(h0, wbh[kk], a0, 0, 0, 0); a2 = __builtin_amdgcn_mfma_f32_16x16x32_f16(h1, wbh[kk + 1], a2, 0, 0, 0); }
#pragma unroll
            for (int r = 0; r < 4; ++r) PL[(kh * 16 + 4 * fq + r) * 64 + 16 * nt + fr] = a0[r] + a2[r];
        }
        __syncthreads();
#pragma unroll 1
        for (int rr = 0; rr < 2; ++rr) {
            const int lr = 2 * w + rr; const float logit = PL[lr * 64 + lane] + PL[(16 + lr) * 64 + lane];
            const float score = 1.0f / (1.0f + expf(-logit)); float sb = score + rbias; sb = (sb == sb) ? sb : -1.0f; int rank = 0;
#pragma unroll 8
            for (int j = 0; j < 64; ++j) { const float o = __builtin_bit_cast(float, __builtin_amdgcn_readlane(__builtin_bit_cast(int, sb), j)); rank += (o > sb || (o == sb && j < lane)) ? 1 : 0; }
            const bool sel = rank < TOPK; const float ssum = wave_sum(sel ? score : 0.f);
            if (sel) { const int lidx = __hip_atomic_fetch_add(lcnt + lane, 1, __ATOMIC_RELAXED, __HIP_MEMORY_SCOPE_WORKGROUP);
                selP[(gi * 16 + lr) * 8 + rank] = lane | (lidx << 8); selG[(gi * 16 + lr) * 8 + rank] = 2.5f * score / ssum; }
        }
        __syncthreads();
    }
    if (tid < 64) lbase[tid] = (int)__hip_atomic_fetch_add(F.ctl() + (F.dry ? CW_CNT2 : CW_CNT) + 16 * tid, (unsigned)lcnt[tid], __ATOMIC_RELAXED, __HIP_MEMORY_SCOPE_AGENT);
    __syncthreads();
    for (int i = tid; i < gi * 128; i += 512) { const int lr = i >> 3, k = i & 7, row = 16 * (F.bid + (lr >> 4) * F.G) + (lr & 15);
        const int p = selP[i], e = p & 255, pos = lbase[e] + (p >> 8);
        F.ROWTAB()[(size_t)e * 16384 + pos] = row; F.EIDX()[row * 8 + k] = e; F.EPOS()[row * 8 + k] = pos; F.EGATE()[row * 8 + k] = selG[i]; }
#undef P8_LOAD
}

DI void moe_tiles_to_lds(const Ctx& F) {
    LAS int* tb = (LAS int*)(F.lds + LDS_TB); LAS int* cn = tb + 66; LAS int* sxb = tb + 132;
    if (F.tid < 64) { const int c = (int)__hip_atomic_load(F.ctl() + CW_CNT + 16 * F.tid, __ATOMIC_RELAXED, __HIP_MEMORY_SCOPE_AGENT); const int nt = (c + 255) >> 8;
        float fi = scan_add((float)nt, F.lane); const int incl = (int)(fi + 0.5f);
        tb[F.tid] = incl - nt; cn[F.tid] = c; if (F.tid == 63) { tb[64] = incl; tb[65] = incl + 64; cn[64] = MX; } }
    __syncthreads();
    if (F.tid == 0) { const int T = tb[65]; int prev = 0; sxb[0] = 0;
        for (int x = 0; x < 8; ++x) { int sh = ((x + 1) * T + 4) / 8 - tb[8 * x + 8]; sh = sh < prev ? prev : sh; sh = sh > 64 ? 64 : sh; if (x == 7) sh = 64; sxb[x + 1] = sh; prev = sh; } }
    __syncthreads();
}
DI int moe_find(const LAS int* tb, int tt) { int e = 0;
#pragma unroll
    for (int s = 64; s >= 1; s >>= 1) if (e + s <= 64 && tb[e + s] <= tt) e += s;
    return e; }
DI bool moe_unit(const LAS int* tb, int G, int c, int i, int upt  , int& tt, int& pn, int& e) {
    const LAS int* sxb = tb + 132; const int x = c & 7, idx = (c >> 3) + i * (G >> 3);
    const int own = upt * (tb[8 * x + 8] - tb[8 * x]), sh = upt * (sxb[x + 1] - sxb[x]);
    if (idx >= own + sh) return false;
    if (idx < own) { tt = tb[8 * x] + idx / upt; pn = idx % upt; e = 0;
#pragma unroll
        for (int q = 1; q < 8; ++q) e += (tb[8 * x + q] <= tt) ? 1 : 0;
        e += 8 * x; }
    else { const int su = idx - own; tt = tb[64] + sxb[x] + su / upt; pn = su % upt; e = 64; }
    tt = __builtin_amdgcn_readfirstlane(tt); pn = __builtin_amdgcn_readfirstlane(pn); e = __builtin_amdgcn_readfirstlane(e);
    return true;
}
struct Moe1Order {
    struct Unit { int tt, pn, e, slot; }; static constexpr bool GATHER = true;
    int G, c; const bf16* WguT; const LAS int* tb; const LAS int* rowL;
    DI bool next(int i, Unit& u) const { if (i >= MOE1_SLOTS) return false; u.slot = i; return moe_unit(tb, G, c, i, 2, u.tt, u.pn, u.e); }
    DI void a_off(const Unit& u, const int (&R)[2], const int (&C)[2], unsigned (&off)[2][2]) const {
#pragma unroll
        for (int h = 0; h < 2; ++h)
#pragma unroll
            for (int i = 0; i < 2; ++i) off[h][i] = (unsigned)(rowL[u.slot * 256 + h * 128 + R[i]] * 1024 + C[i]) * 2u; }
    DI const char* b_ptr(const Unit& u) const { return (const char*)(WguT + ((size_t)u.e * 512 + u.pn * 256) * 1024); }
};
struct EpiGu {
    static constexpr bool PERM = true;
    bf16* HB;
    DI void operator()(const f32x4 (&acc)[2][2][4][2], const Moe1Order::Unit& u, int wr, int wc, int fr, int fq) const {
        const int row0 = u.tt * 256 + wr * 64 + fr, col0 = u.pn * 128 + wc * 32 + 8 * fq;
#pragma unroll
        for (int ai = 0; ai < 2; ++ai)
#pragma unroll
            for (int m = 0; m < 4; ++m) { const f32x4 g0 = acc[ai][0][m][0], g1 = acc[ai][0][m][1], u0 = acc[ai][1][m][0], u1 = acc[ai][1][m][1];
                u32x4 w; w.x = pg8::cvt_pk_bf16(siluf(g0[0]) * u0[0], siluf(g0[1]) * u0[1]); w.y = pg8::cvt_pk_bf16(siluf(g0[2]) * u0[2], siluf(g0[3]) * u0[3]);
                w.z = pg8::cvt_pk_bf16(siluf(g1[0]) * u1[0], siluf(g1[1]) * u1[1]); w.w = pg8::cvt_pk_bf16(siluf(g1[2]) * u1[2], siluf(g1[3]) * u1[3]);
                *(u32x4*)(HB + (size_t)(row0 + ai * 128 + m * 16) * 256 + col0) = w; }
    }
};
struct Moe2Order {
    struct Unit { int tt, pn, e; }; static constexpr bool GATHER = false;
    int G, c; const bf16* WdT; const LAS int* tb; const bf16* A;
    DI bool next(int i, Unit& u) const { return moe_unit(tb, G, c, i, 4, u.tt, u.pn, u.e); }
    DI const char* a_ptr(const Unit& u) const { return (const char*)(A + (size_t)u.tt * 256 * 256); }
    DI const char* b_ptr(const Unit& u) const { return (const char*)(WdT + ((size_t)u.e * 1024 + u.pn * 256) * 256); }
};
constexpr float YB_SCALE = 32.0f;
struct EpiDn {
    static constexpr bool PERM = true;
    unsigned char* YB;
    DI void operator()(const f32x4 (&acc)[2][2][4][2], const Moe2Order::Unit& u, int wr, int wc, int fr, int fq) const {
        const int row0 = u.tt * 256 + wr * 64 + fr, col0 = u.pn * 256 + wc * 32 + 8 * fq;
#pragma unroll
        for (int ai = 0; ai < 2; ++ai)
#pragma unroll
            for (int m = 0; m < 4; ++m) { unsigned char* rowp = YB + (size_t)(row0 + ai * 128 + m * 16) * 1024 + col0;
#pragma unroll
                for (int bj = 0; bj < 2; ++bj) { f32x4 v0 = acc[ai][bj][m][0] * YB_SCALE, v1 = acc[ai][bj][m][1] * YB_SCALE;
#pragma unroll
                    for (int q = 0; q < 4; ++q) { v0[q] = __builtin_amdgcn_fmed3f(v0[q], -448.f, 448.f); v1[q] = __builtin_amdgcn_fmed3f(v1[q], -448.f, 448.f); }
                    int p0 = __builtin_amdgcn_cvt_pk_fp8_f32(v0[0], v0[1], 0, false); p0 = __builtin_amdgcn_cvt_pk_fp8_f32(v0[2], v0[3], p0, true);
                    int p1 = __builtin_amdgcn_cvt_pk_fp8_f32(v1[0], v1[1], 0, false); p1 = __builtin_amdgcn_cvt_pk_fp8_f32(v1[2], v1[3], p1, true);
                    u32x2 w; w.x = (unsigned)p0; w.y = (unsigned)p1; *(u32x2*)(rowp + bj * 128) = w; } }
    }
};
DI void p9_fill_rows(const Ctx& F) {
    const LAS int* tb = (const LAS int*)(F.lds + LDS_TB); const LAS int* cn = tb + 66; LAS int* rowL = (LAS int*)(F.lds + LDS_ROWL);
    for (int i = 0; i < MOE1_SLOTS; ++i) { int tt, pn, e; if (!moe_unit(tb, F.G, F.bid, i, 2, tt, pn, e)) break; const int rt = tt - tb[e];
        if (F.tid < 256) { const int r = 256 * rt + F.tid; rowL[i * 256 + F.tid] = e < 64 ? (r < cn[e] ? F.ROWTAB()[(size_t)e * 16384 + r] : 0) : r; } }
    __syncthreads();
}
DI void p11_acc(float (&acc)[16], float g, const u32x4 q) {
    const unsigned wv[4] = {q.x, q.y, q.z, q.w};
#pragma unroll
    for (int i = 0; i < 4; ++i) { const f32x2 lo = __builtin_amdgcn_cvt_pk_f32_fp8((int)wv[i], false), hi = __builtin_amdgcn_cvt_pk_f32_fp8((int)wv[i], true);
        acc[4 * i] += g * lo.x; acc[4 * i + 1] += g * lo.y; acc[4 * i + 2] += g * hi.x; acc[4 * i + 3] += g * hi.y; } }
DI void p11_combine(const Ctx& F) {
    LAS float* modL = (LAS float*)F.lds;
    const LAS int* tb = (const LAS int*)(F.lds + LDS_TB);
    for (int i = F.tid; i < 4 * 1024; i += 512) modL[i] = F.MOD()[(i >> 10) * 6144 + 5120 + (i & 1023)];
    __syncthreads();
    const int lane = F.lane, gw = F.bid * 8 + F.wave, NGW = F.G * 8;
    const unsigned char* YB8 = (const unsigned char*)F.YB();
    u32x4 q[9], qn[9]; u32x4 xv[2], xvn[2]; float gg[9], ggn[9]; int ei[8], pi[8]; float gi[8];
#define P11_IDX(r) { const int* ep_ = F.EIDX() + (r) * 8; const int* pp_ = F.EPOS() + (r) * 8; const float* gp_ = F.EGATE() + (r) * 8; \
        _Pragma("unroll") for (int k = 0; k < 8; ++k) { ei[k] = ep_[k]; pi[k] = pp_[k]; gi[k] = gp_[k]; } }
#define P11_ISSUE(r, Q, X, G) { _Pragma("unroll") for (int k = 0; k < 8; ++k) { Q[k] = *(const u32x4*)(YB8 + (size_t)(tb[ei[k]] * 256 + pi[k]) * 1024 + 16 * lane); G[k] = gi[k] * (1.0f / YB_SCALE); } \
        Q[8] = *(const u32x4*)(YB8 + (size_t)(tb[64] * 256 + (r)) * 1024 + 16 * lane); G[8] = 1.0f / YB_SCALE; \
        _Pragma("unroll") for (int i = 0; i < 2; ++i) X[i] = *(const u32x4*)(F.X1() + (size_t)(r) * 1024 + 16 * lane + 8 * i); }
    int row = gw;
    if (row < MX) { P11_IDX(row) P11_ISSUE(row, q, xv, gg) if (row + NGW < MX) P11_IDX(row + NGW) }
    while (row < MX) {
        const int nrow = row + NGW;
        if (nrow < MX) { P11_ISSUE(nrow, qn, xvn, ggn) if (nrow + NGW < MX) P11_IDX(nrow + NGW) }
        float* orow = F.out + (size_t)row * 1024; const LAS float* md = modL + (row >> 12) * 1024;
        float acc[16];
#pragma unroll
        for (int j = 0; j < 16; ++j) acc[j] = 0.f;
#pragma unroll
        for (int k = 0; k < 9; ++k) p11_acc(acc, gg[k], q[k]);
        float v[16]; float s = 0.f;
#pragma unroll
        for (int i = 0; i < 4; ++i) { const f32x4 g4 = *(const LAS f32x4*)(md + 16 * lane + 4 * i); const unsigned xw0 = (i & 1) ? xv[i >> 1].z : xv[i >> 1].x, xw1 = (i & 1) ? xv[i >> 1].w : xv[i >> 1].y;
            v[4 * i] = ALPHA * bflo(xw0) + g4.x * acc[4 * i]; v[4 * i + 1] = ALPHA * bfhi(xw0) + g4.y * acc[4 * i + 1]; v[4 * i + 2] = ALPHA * bflo(xw1) + g4.z * acc[4 * i + 2]; v[4 * i + 3] = ALPHA * bfhi(xw1) + g4.w * acc[4 * i + 3];
            s += (v[4 * i] + v[4 * i + 1]) + (v[4 * i + 2] + v[4 * i + 3]); }
        const float mean = wave_sum(s) * (1.0f / 1024.0f); float s2 = 0.f;
#pragma unroll
        for (int j = 0; j < 16; ++j) { v[j] -= mean; s2 += v[j] * v[j]; }
        const float rstd = 1.0f / sqrtf(wave_sum(s2) * (1.0f / 1024.0f) + LN_EPS);
#pragma unroll
        for (int i = 0; i < 4; ++i) { const int c0 = 16 * lane + 4 * i; const f32x4 ga = *(const f32x4*)(F.ln2_g + c0), ba = *(const f32x4*)(F.ln2_b + c0);
            f32x4 o; o.x = v[4 * i] * rstd * ga.x + ba.x; o.y = v[4 * i + 1] * rstd * ga.y + ba.y; o.z = v[4 * i + 2] * rstd * ga.z + ba.z; o.w = v[4 * i + 3] * rstd * ga.w + ba.w;
            *(f32x4*)(orow + c0) = o; }
#pragma unroll
        for (int k = 0; k < 9; ++k) { q[k] = qn[k]; gg[k] = ggn[k]; }
#pragma unroll
        for (int i = 0; i < 2; ++i) xv[i] = xvn[i];
        row = nrow;
    }
#undef P11_IDX
#undef P11_ISSUE
}

constexpr int NPHASE = 12;
__global__ void __launch_bounds__(512, 2) mk_fwd(Args args) {
    extern __shared__ __attribute__((aligned(16))) unsigned char lds_raw[];
    Ctx F;
    F.lds = (LAS unsigned char*)lds_raw;
    F.tid = threadIdx.x; F.lane = F.tid & 63; F.wave = __builtin_amdgcn_readfirstlane(F.tid >> 6); F.G = gridDim.x; F.bid = blockIdx.x; F.dry = args.pad;
    F.x = args.in[0]; F.c = args.in[1]; F.ctx = args.in[2]; F.c_ctx = args.in[3]; F.w_ada = args.in[4]; F.b_ada = args.in[5]; F.w_in = args.in[6]; F.conv_w = args.in[7]; F.conv_b = args.in[8];
    F.gate_b = args.in[9]; F.head_g = args.in[10]; F.w_out = args.in[11]; F.ln1_g = args.in[12]; F.ln1_b = args.in[13]; F.w_router = args.in[14]; F.router_bias = args.in[15];
    F.w_egu = args.in[16]; F.w_ed = args.in[17]; F.w_sgu = args.in[18]; F.w_sd = args.in[19]; F.ln2_g = args.in[20]; F.ln2_b = args.in[21];
    F.out = args.out; F.ws = args.ws;
    volatile LAS unsigned* MISC = (volatile LAS unsigned*)(F.lds + LDS_MISC);
    for (int u = F.tid; u < (LDS_BYTES - LDS_MISC) / 4; u += 512) MISC[u] = 0u;
    __syncthreads();
    XcdBarrier bar; bar.bar = F.ctl() + CW_BAR; bar.x = 0; bar.st = nullptr;
    if (MK_N_LAUNCHES == 1) bar = xcd_barrier_post(F.ctl() + CW_BAR, MISC + 8);
    const int lo = args.ph_lo, hi = args.ph_hi;
#define IN(k) (lo <= (k) && (k) < hi)
#define SEAM(k) do { if (IN(k) && IN((k) + 1)) xcd_barrier(bar); } while (0)
#ifndef PROBE_REP
#define PROBE_REP -1
#endif

    if (IN(0)) { p0_prologue(F); }
    if (IN(1)) { p1_lnmod(F); } SEAM(1);
    if (IN(2)) { ProjOrder S{F.G, F.bid, F.WINT(), F.XN()}; EpiProj E{F.PROJ(), F.FCS()}; pg8::gemm_phase<EpiProj, ProjOrder, GEMM_SP2, GEMM_ALIGN>(F.lds, (const char*)F.XN(), 1024, S, E);
        if (F.G == 256 && MK_N_LAUNCHES == 1 && F.bid >= P2_BUSY)
            p0_transposes(F, (LAS float*)(F.lds + F.wave * 17408), T_EARLY + (F.bid - P2_BUSY) * 8 + F.wave, (256 - P2_BUSY) * 8, T_ALL); } SEAM(2);
    if (IN(3)) { p3_conv(F); } SEAM(3);
    if (IN(4)) { for (int it = F.bid; it < NITEM4; it += F.G) p4_item(F, it); } SEAM(4);
    if (IN(5)) { p5_scan(F); } SEAM(5);
    if (IN(6)) { if (F.dry != 2) for (int it = F.bid; it < 512; it += F.G) p6_mlstm_item(F, it);
                 if (F.dry != 1) for (int it = F.bid; it < 256; it += F.G) p6_fourier_item(F, it); } SEAM(6);
    if (IN(7)) { OutOrder S{F.G, F.bid, F.WOUTT(), F.MIXIN()}; EpiMix E{F.MIXB()}; pg8::gemm_phase<EpiMix, OutOrder, GEMM_SP2, GEMM_ALIGN>(F.lds, (const char*)F.MIXIN(), 1024, S, E); } SEAM(7);
    if (IN(8)) { p8_rows(F); } SEAM(8);
    if (IN(9)) { moe_tiles_to_lds(F); p9_fill_rows(F);
        Moe1Order S{F.G, F.bid, F.WGUT(), (const LAS int*)(F.lds + LDS_TB), (const LAS int*)(F.lds + LDS_ROWL)}; EpiGu E{F.HB()};
        pg8::gemm_phase<EpiGu, Moe1Order, GEMM_SP2, GEMM_ALIGN>(F.lds, (const char*)F.T(), 1024, S, E); } SEAM(9);
    if (IN(10)) { moe_tiles_to_lds(F); Moe2Order S{F.G, F.bid, F.WDT(), (const LAS int*)(F.lds + LDS_TB), F.HB()}; EpiDn E{(unsigned char*)F.YB()};
        pg8::gemm_phase<EpiDn, Moe2Order, GEMM_SP2, GEMM_ALIGN>(F.lds, (const char*)F.HB(), 256, S, E); } SEAM(10);
    if (IN(11)) { moe_tiles_to_lds(F); p11_combine(F); }
#undef IN
#undef SEAM
}

extern "C" void kernel_launch(void* const* d_in, const int* in_sizes, int n_in, void* d_out, int out_size, void* d_ws, size_t ws_size, hipStream_t stream) {
    static int grid = 0;
    if (grid == 0) {
        if (n_in != 22 || out_size != MX * DM || ws_size < WS_END) { fprintf(stderr, "kernel_launch: unexpected problem (n_in %d, out %d, ws %zu)\n", n_in, out_size, ws_size); grid = -1; return; }
        int dev = 0, cus = 0, per_cu = 0;
        if (hipGetDevice(&dev) != hipSuccess || hipDeviceGetAttribute(&cus, hipDeviceAttributeMultiprocessorCount, dev) != hipSuccess) { grid = -1; return; }
        if (hipFuncSetAttribute((const void*)mk_fwd, hipFuncAttributeMaxDynamicSharedMemorySize, LDS_BYTES) != hipSuccess) { fprintf(stderr, "kernel_launch: hipFuncSetAttribute failed\n"); grid = -1; return; }
        if (hipOccupancyMaxActiveBlocksPerMultiprocessor(&per_cu, (const void*)mk_fwd, 512, LDS_BYTES) != hipSuccess || per_cu < 1) { fprintf(stderr, "kernel_launch: occupancy query says %d\n", per_cu); per_cu = 1; }
        (void)hipGetLastError();
        grid = cus;
        if (grid > 256) grid = 256;
        grid &= ~7;
    }
    if (grid < 0) return;
    (void)in_sizes;
    if (hipMemsetAsync((char*)d_ws + WS_CTL, 0, CTL_ZERO_BYTES, stream) != hipSuccess) return;
    Args a{};
    for (int i = 0; i < 22; ++i) a.in[i] = (const float*)d_in[i];
    a.out = (float*)d_out; a.ws = (unsigned char*)d_ws;
    for (int li = 0; li < MK_N_LAUNCHES; ++li) {
        a.ph_lo = (MK_N_LAUNCHES == 1) ? 0 : li; a.ph_hi = (MK_N_LAUNCHES == 1) ? NPHASE : li + 1; a.li = li; a.pad = 0;
        if (MK_N_LAUNCHES > 1 && li == PROBE_REP) { a.pad = 1; hipLaunchKernelGGL(mk_fwd, dim3(grid), dim3(512), LDS_BYTES, stream, a); a.pad = 0; }
        if (MK_N_LAUNCHES > 1 && li == PROBE_REP - 200) { a.pad = 2; hipLaunchKernelGGL(mk_fwd, dim3(grid), dim3(512), LDS_BYTES, stream, a); a.pad = 0; }
        if (MK_N_LAUNCHES > 1 && li == PROBE_REP - 100) { a.pad = 1; for (int q = 0; q < 3; ++q) hipLaunchKernelGGL(mk_fwd, dim3(grid), dim3(512), LDS_BYTES, stream, a); a.pad = 0; }
        hipLaunchKernelGGL(mk_fwd, dim3(grid), dim3(512), LDS_BYTES, stream, a);
    }
}
```

```cpp
#include <hip/hip_runtime.h>
#include <cstdio>
#include <cstdint>

#ifndef GEMM_SP2
#define GEMM_SP2 true
#endif
#ifndef GEMM_ALIGN
#define GEMM_ALIGN false
#endif
#ifndef MK_N_LAUNCHES
#define MK_N_LAUNCHES 1
#endif

#define LAS __attribute__((address_space(3)))
#define DI __device__ __forceinline__
typedef unsigned short bf16;
typedef float f32x4 __attribute__((ext_vector_type(4)));
typedef float f32x2 __attribute__((ext_vector_type(2)));
typedef short bf16x8 __attribute__((ext_vector_type(8)));
typedef unsigned u32x4 __attribute__((ext_vector_type(4)));
typedef unsigned u32x2 __attribute__((ext_vector_type(2)));

constexpr int NB = 4, SEQ = 4096, DM = 1024, CTXL = 256;
constexpr int MX = NB * SEQ;
constexpr int MC = NB * CTXL;
constexpr int MALL = MX + MC;
constexpr int NH = 4, HD = 128;
constexpr int DINP = 2576;
constexpr int NE = 64, TOPK = 8, DE = 256;
constexpr int NCH = 34;
constexpr int NITEM4 = 32 * NCH;
constexpr float LN_EPS = 1e-5f;
constexpr float ALPHA = 1.189207115002721f;
constexpr int MAXTILES = 640;

constexpr size_t MiB = 1u << 20;
constexpr size_t WS_CTL = 0, CTL_ZERO_BYTES = 1 * MiB;
constexpr size_t WS_MODP = 446 * MiB;
constexpr size_t WS_TAB = 2 * MiB;
constexpr size_t WS_GL = 3 * MiB;
constexpr size_t WS_ROWTAB = 5 * MiB;
constexpr size_t WS_EIDX = 9 * MiB;
constexpr size_t WS_EPOS = 9 * MiB + 512 * 1024;
constexpr size_t WS_EGATE = 10 * MiB;
constexpr size_t WS_SC = 11 * MiB;
constexpr size_t WS_NHAT = 11 * MiB + 64 * 1024;
constexpr size_t WS_NIN = 12 * MiB;
constexpr size_t WS_MIN = 12 * MiB + 512 * 1024;
constexpr size_t WS_WDT = 13 * MiB;
constexpr size_t WS_HB = 46 * MiB;
constexpr size_t WS_YB = 126 * MiB;
constexpr size_t WS_WGUT = 126 * MiB;
constexpr size_t WS_T = 191 * MiB;
constexpr size_t WS_WINT = 223 * MiB;
constexpr size_t WS_WOUTT = 229 * MiB;
constexpr size_t WS_XN = 231 * MiB;
constexpr size_t WS_MIXIN = 231 * MiB;
constexpr size_t WS_PROJ = 265 * MiB;
constexpr size_t WS_FCS = 333 * MiB;
constexpr size_t WS_QK = 365 * MiB;
constexpr size_t WS_CHAT = 399 * MiB;
constexpr size_t WS_CIN = 467 * MiB;
constexpr size_t WS_X1 = 446 * MiB;
constexpr size_t WS_MIXB = 265 * MiB;
constexpr size_t WS_END = 512 * MiB;
static_assert(WS_YB + (size_t)MAXTILES * 256 * 1024 * 2 <= WS_END, "YB");
static_assert(WS_CIN + (size_t)32 * 32 * 16384 * 2 <= WS_END, "CIN");
constexpr int CW_TMO = 0;
constexpr int CW_BAR = 4096;
constexpr int CW_CNT = 16384;
constexpr int CW_CNT2 = 24576;
constexpr int CW_MODDONE = 28672;
constexpr int CW_ADA = 20480;
constexpr int LDS_BYTES = 147456;
constexpr int LDS_ROWL = 131072;
constexpr int MOE1_SLOTS = 14;
constexpr int LDS_TB = 145408;
constexpr int LDS_MISC = 146432;

DI unsigned pk2(float lo, float hi) { unsigned r; asm("v_cvt_pk_bf16_f32 %0, %1, %2" : "=v"(r) : "v"(lo), "v"(hi)); return r; }
DI unsigned f2bf(float f) { return pk2(f, 0.f) & 0xffffu; }
typedef _Float16 f16x8 __attribute__((ext_vector_type(8)));
typedef _Float16 f16x2 __attribute__((ext_vector_type(2)));
DI unsigned pkh2(float lo, float hi) { const f16x2 h = (f16x2){(_Float16)lo, (_Float16)hi}; return __builtin_bit_cast(unsigned, h); }
DI float bf2f(unsigned b) { return __builtin_bit_cast(float, b << 16); }
DI float bflo(unsigned w) { return __builtin_bit_cast(float, w << 16); }
DI float bfhi(unsigned w) { return __builtin_bit_cast(float, w & 0xffff0000u); }
#define DPPF(x, ctrl) __builtin_bit_cast(float, __builtin_amdgcn_update_dpp(0, __builtin_bit_cast(int, (x)), (ctrl), 0xf, 0xf, false))
DI float red16(float v) { v += DPPF(v, 0xB1); v += DPPF(v, 0x4E); v += DPPF(v, 0x141); v += DPPF(v, 0x140); return v; }
DI float max16(float v) { v = fmaxf(v, DPPF(v, 0xB1)); v = fmaxf(v, DPPF(v, 0x4E)); v = fmaxf(v, DPPF(v, 0x141)); v = fmaxf(v, DPPF(v, 0x140)); return v; }
DI float rdl(float v, int l) { return __builtin_bit_cast(float, __builtin_amdgcn_readlane(__builtin_bit_cast(int, v), l)); }
DI float wave_sum(float v) { v = red16(v); return (rdl(v, 0) + rdl(v, 16)) + (rdl(v, 32) + rdl(v, 48)); }
DI float wave_max(float v) { v = max16(v); return fmaxf(fmaxf(rdl(v, 0), rdl(v, 16)), fmaxf(rdl(v, 32), rdl(v, 48))); }
DI int wave_min_i(int v) {
#pragma unroll
    for (int o = 1; o < 64; o <<= 1) { const int t = __shfl_xor(v, o); v = t < v ? t : v; }
    return v;
}
DI float scan_add(float x, int lane) {
#pragma unroll
    for (int o = 1; o < 64; o <<= 1) { const float t = __shfl_up(x, o); if (lane >= o) x += t; }
    return x;
}
DI float scan_max(float x, int lane) {
#pragma unroll
    for (int o = 1; o < 64; o <<= 1) { const float t = __shfl_up(x, o); if (lane >= o) x = fmaxf(x, t); }
    return x;
}
DI float siluf(float v) { return v * __builtin_amdgcn_rcpf(1.0f + __expf(-v)); }
DI float sigmf(float v) { return __builtin_amdgcn_rcpf(1.0f + __expf(-v)); }
DI float logsigf(float x) { return x >= 0.f ? -log1pf(expf(-x)) : x - log1pf(expf(x)); }
#define LDS_WAIT() asm volatile("s_waitcnt lgkmcnt(0)" ::: "memory")
#define VM_WAIT() asm volatile("s_waitcnt vmcnt(0)" ::: "memory")
#define MFMA16(a, b, c) __builtin_amdgcn_mfma_f32_16x16x32_bf16((a), (b), (c), 0, 0, 0)

DI unsigned lds_addr(const LAS void* p) { return (unsigned)(size_t)p; }
template <int ST, int KG> DI unsigned tr_base(unsigned tile, int lane) { return tile + (unsigned)((KG * (lane >> 4) + ((lane & 15) >> 2)) * ST + 8 * (lane & 3)); }
template <int O0, int O1> DI bf16x8 tr2(unsigned a) { u32x2 lo, hi;
    asm volatile("ds_read_b64_tr_b16 %0, %2 offset:%3\n\tds_read_b64_tr_b16 %1, %2 offset:%4\n\ts_waitcnt lgkmcnt(0)" : "=&v"(lo), "=&v"(hi) : "v"(a), "n"(O0), "n"(O1) : "memory");
    u32x4 r; r.x = lo.x; r.y = lo.y; r.z = hi.x; r.w = hi.y; return __builtin_bit_cast(bf16x8, r); }
template <int OB, int D2> DI void tr2x8(unsigned a, bf16x8 (&f)[8]) { u32x2 l0, l1, l2, l3, l4, l5, l6, l7, h0, h1, h2, h3, h4, h5, h6, h7;
    asm volatile("ds_read_b64_tr_b16 %0, %16 offset:%17\n\tds_read_b64_tr_b16 %1, %16 offset:%18\n\tds_read_b64_tr_b16 %2, %16 offset:%19\n\tds_read_b64_tr_b16 %3, %16 offset:%20\n\t"
                 "ds_read_b64_tr_b16 %4, %16 offset:%21\n\tds_read_b64_tr_b16 %5, %16 offset:%22\n\tds_read_b64_tr_b16 %6, %16 offset:%23\n\tds_read_b64_tr_b16 %7, %16 offset:%24\n\t"
                 "ds_read_b64_tr_b16 %8, %16 offset:%25\n\tds_read_b64_tr_b16 %9, %16 offset:%26\n\tds_read_b64_tr_b16 %10, %16 offset:%27\n\tds_read_b64_tr_b16 %11, %16 offset:%28\n\t"
                 "ds_read_b64_tr_b16 %12, %16 offset:%29\n\tds_read_b64_tr_b16 %13, %16 offset:%30\n\tds_read_b64_tr_b16 %14, %16 offset:%31\n\tds_read_b64_tr_b16 %15, %16 offset:%32\n\ts_waitcnt lgkmcnt(0)"
                 : "=&v"(l0), "=&v"(l1), "=&v"(l2), "=&v"(l3), "=&v"(l4), "=&v"(l5), "=&v"(l6), "=&v"(l7), "=&v"(h0), "=&v"(h1), "=&v"(h2), "=&v"(h3), "=&v"(h4), "=&v"(h5), "=&v"(h6), "=&v"(h7)
                 : "v"(a), "n"(OB), "n"(OB + 32), "n"(OB + 64), "n"(OB + 96), "n"(OB + 128), "n"(OB + 160), "n"(OB + 192), "n"(OB + 224),
                   "n"(OB + D2), "n"(OB + D2 + 32), "n"(OB + D2 + 64), "n"(OB + D2 + 96), "n"(OB + D2 + 128), "n"(OB + D2 + 160), "n"(OB + D2 + 192), "n"(OB + D2 + 224) : "memory");
#define TRP_(i, L, H) { u32x4 r; r.x = L.x; r.y = L.y; r.z = H.x; r.w = H.y; f[i] = __builtin_bit_cast(bf16x8, r); }
    TRP_(0, l0, h0) TRP_(1, l1, h1) TRP_(2, l2, h2) TRP_(3, l3, h3) TRP_(4, l4, h4) TRP_(5, l5, h5) TRP_(6, l6, h6) TRP_(7, l7, h7)
#undef TRP_
}

template <int OB, int D2> DI void tr2x4(unsigned a, bf16x8 (&f)[4]) { u32x2 l0, l1, l2, l3, h0, h1, h2, h3;
    asm volatile("ds_read_b64_tr_b16 %0, %8 offset:%9\n\tds_read_b64_tr_b16 %1, %8 offset:%10\n\tds_read_b64_tr_b16 %2, %8 offset:%11\n\tds_read_b64_tr_b16 %3, %8 offset:%12\n\t"
                 "ds_read_b64_tr_b16 %4, %8 offset:%13\n\tds_read_b64_tr_b16 %5, %8 offset:%14\n\tds_read_b64_tr_b16 %6, %8 offset:%15\n\tds_read_b64_tr_b16 %7, %8 offset:%16\n\ts_waitcnt lgkmcnt(0)"
                 : "=&v"(l0), "=&v"(l1), "=&v"(l2), "=&v"(l3), "=&v"(h0), "=&v"(h1), "=&v"(h2), "=&v"(h3)
                 : "v"(a), "n"(OB), "n"(OB + 32), "n"(OB + 64), "n"(OB + 96), "n"(OB + D2), "n"(OB + D2 + 32), "n"(OB + D2 + 64), "n"(OB + D2 + 96) : "memory");
#define TRP_(i, L, H) { u32x4 r; r.x = L.x; r.y = L.y; r.z = H.x; r.w = H.y; f[i] = __builtin_bit_cast(bf16x8, r); }
    TRP_(0, l0, h0) TRP_(1, l1, h1) TRP_(2, l2, h2) TRP_(3, l3, h3)
#undef TRP_
}

#define XB_TMO      128
#define XB_XCNT(j)  (256  + 64 * (j))
#define XB_XSUB(j)  (1280 + 64 * (j))
#define XB_XGEN(j)  (2304 + 64 * (j))
#define XB_TOP      3328
#define XB_TOPGEN   3392
#define XCD_BAR_WORDS 3456
#define XB_SPIN_CAP (1u << 18)
DI unsigned xb_ld(unsigned* p)              { return __hip_atomic_load(p, __ATOMIC_RELAXED, __HIP_MEMORY_SCOPE_AGENT); }
DI unsigned xb_add(unsigned* p, unsigned v) { return __hip_atomic_fetch_add(p, v, __ATOMIC_RELAXED, __HIP_MEMORY_SCOPE_AGENT); }
DI unsigned xb_xcc_id() { return (unsigned)__builtin_amdgcn_s_getreg((3 << 11) | 20) & 0xFu; }
#define XB_SPIN(cond, bar) do { unsigned _sp = 0; while (cond) { __builtin_amdgcn_s_sleep(1); \
    if ((++_sp & 255u) == 0u) { if (xb_ld(&(bar)[XB_TMO])) break; if (_sp > XB_SPIN_CAP) { atomicAdd(&(bar)[XB_TMO], 1u); break; } } } } while (0)
struct XcdBarrier { unsigned* bar; unsigned x; volatile LAS unsigned* st; };
DI XcdBarrier xcd_barrier_post(unsigned* bar, volatile LAS unsigned* st) {
    XcdBarrier b; b.bar = bar; b.x = xb_xcc_id(); b.st = st;
    if (threadIdx.x == 0) (void)xb_add(&bar[XB_XCNT(b.x)], 1u);
    return b;
}
DI void xcd_barrier_complete(unsigned* bar, unsigned x, unsigned& nloc, unsigned& nx) {
    const unsigned G = gridDim.x * gridDim.y * gridDim.z;
    unsigned sum, cnt, mine, sp = 0u;
    for (;;) {
        sum = 0u; cnt = 0u; mine = 0u;
#pragma unroll
        for (unsigned j = 0; j < 16; ++j) { const unsigned c = xb_ld(&bar[XB_XCNT(j)]); sum += c; cnt += (c > 0u) ? 1u : 0u; mine = (j == x) ? c : mine; }
        if (sum == G) break;
        __builtin_amdgcn_s_sleep(1);
        if ((++sp & 255u) == 0u) { if (xb_ld(&bar[XB_TMO])) break; if (sp > XB_SPIN_CAP) { atomicAdd(&bar[XB_TMO], 1u); break; } }
    }
    nloc = mine > 0u ? mine : 1u; nx = cnt > 0u ? cnt : 1u;
}
DI void xcd_barrier(const XcdBarrier& b) {
    asm volatile("s_waitcnt vmcnt(0)" ::: "memory");
    __syncthreads();
    if (threadIdx.x == 0) {
        unsigned* bar = b.bar;
        __builtin_amdgcn_s_waitcnt(0);
        unsigned nloc = b.st[0], nx = b.st[1];
        if (nloc == 0u) { xcd_barrier_complete(bar, b.x, nloc, nx); b.st[0] = nloc; b.st[1] = nx; }
        const unsigned old = xb_add(&bar[XB_XSUB(b.x)], 1u);
        const unsigned gen = old / nloc;
        if (old + 1u == (gen + 1u) * nloc) {
            __builtin_amdgcn_fence(__ATOMIC_RELEASE, "agent");
            asm volatile("s_waitcnt vmcnt(0)" ::: "memory");
            const unsigned og = xb_add(&bar[XB_TOP], 1u);
            const unsigned tg = og / nx;
            if (og + 1u == (tg + 1u) * nx) xb_add(&bar[XB_TOPGEN], 1u);
            else XB_SPIN(xb_ld(&bar[XB_TOPGEN]) == tg, bar);
            __builtin_amdgcn_fence(__ATOMIC_ACQUIRE, "agent");
            xb_add(&bar[XB_XGEN(b.x)], 1u);
            asm volatile("s_waitcnt vmcnt(0)" ::: "memory");
        } else {
            XB_SPIN(xb_ld(&bar[XB_XGEN(b.x)]) == gen, bar);
            __builtin_amdgcn_fence(__ATOMIC_ACQUIRE, "agent");
            asm volatile("s_waitcnt vmcnt(0)" ::: "memory");
        }
    }
    __syncthreads();
}

namespace pg8 {
constexpr int BM = 256, BK = 64, HALF = 128, HTB = HALF * BK * 2, STAGE_BYTES = 8 * HTB, NXCD = 8, WGM = 8;
__host__ __device__ __forceinline__ int lds_byte(int r, int c) { const int st = (r >> 4) * 2 + (c >> 5), rr = r & 15, cc = c & 31, ob = rr * 64 + cc * 2; return st * 1024 + (ob ^ (((ob >> 9) & 1) << 5)); }
__host__ __device__ __forceinline__ void stage_rc(int b, int& R, int& C) { const int st = b / 1024, sb = b % 1024, swz = sb ^ (((sb >> 9) & 1) << 5); R = (st >> 1) * 16 + swz / 64; C = (st & 1) * 32 + (swz % 64) / 2; }
__host__ __device__ __forceinline__ int perm32(int rho) { const int n = rho >> 4, i = rho & 15; return 8 * (i >> 2) + 4 * n + (i & 3); }
DI unsigned cvt_pk_bf16(float lo, float hi) { unsigned r; asm volatile("v_cvt_pk_bf16_f32 %0, %1, %2" : "=v"(r) : "v"(lo), "v"(hi)); return r; }
DI void static_tile(int L, int nM, int nN, int& pm, int& pn) {
    const int nwg = nM * nN; int wgid = L;
    { const int q = nwg / NXCD, r = nwg % NXCD, xcd = wgid % NXCD, off = wgid / NXCD; wgid = (xcd < r ? xcd * (q + 1) : r * (q + 1) + (xcd - r) * q) + off; }
    const int nig = WGM * nN, gid = wgid / nig, fm = gid * WGM, gsz = (nM - fm) < WGM ? (nM - fm) : WGM;
    pm = fm + ((wgid % nig) % gsz); pn = (wgid % nig) / gsz;
}
template <class Epi, class Sched, bool SP2 = false, bool ALIGN_EPI = false>
DI void gemm_phase(LAS unsigned char* lds, const char* Abase, const int K, const Sched& S, const Epi& E) {
    constexpr bool GA = Sched::GATHER;
    const int tid = threadIdx.x, wid = __builtin_amdgcn_readfirstlane(tid >> 6), lane = tid & 63, wr = wid >> 2, wc = wid & 3, fr = lane & 15, fq = lane >> 4;
    const int nt = K / BK;
    unsigned voffB[2], voffA[2]; int Rr[2], Cc[2];
#pragma unroll
    for (int i = 0; i < 2; ++i) { int R, C; stage_rc(tid * 16 + i * 8192, R, C); Rr[i] = R; Cc[i] = C; const int Rb = Epi::PERM ? ((R & ~31) + perm32(R & 31)) : R; voffB[i] = (unsigned)(Rb * K + C) * 2u; voffA[i] = (unsigned)(R * K + C) * 2u; }
    const size_t kstep = (size_t)(BK * 2);
    const size_t hstep = (size_t)HALF * K * 2;
    const unsigned ldsw = (unsigned)wid * 1024u;
    const int aoff = lds_byte(wr * 64 + fr, fq * 8), boff = lds_byte(wc * 32 + fr, fq * 8);
#define PG8_SA(b, h) (((b) * 2 + (h)) * HTB)
#define PG8_SB(b, h) ((4 + (b) * 2 + (h)) * HTB)
#define PG8_STAGE(bufoff, gbase, voff) do { _Pragma("unroll") for (int _i = 0; _i < 2; ++_i) \
        __builtin_amdgcn_global_load_lds((const unsigned*)((const char*)(gbase) + (voff)[_i]), (LAS unsigned*)(lds + (bufoff) + ldsw + _i * 8192), 16, 0, 0); } while (0)
#define PG8_STAGE_A(bufoff, ptr, h, OFFS) do { if constexpr (GA) { PG8_STAGE(bufoff, ptr, (OFFS)[h]); } else { PG8_STAGE(bufoff, (ptr) + (h) * hstep, voffA); } } while (0)
#define PG8_LDA(dst, b, h) do { _Pragma("unroll") for (int m = 0; m < 4; ++m) _Pragma("unroll") for (int k = 0; k < 2; ++k) dst[m][k] = *(const LAS bf16x8*)(lds + PG8_SA(b, h) + aoff + m * 2048 + k * 1024); } while (0)
#define PG8_LDB(dst, b, h) do { _Pragma("unroll") for (int n = 0; n < 2; ++n) _Pragma("unroll") for (int k = 0; k < 2; ++k) dst[n][k] = *(const LAS bf16x8*)(lds + PG8_SB(b, h) + boff + n * 2048 + k * 1024); } while (0)
#define PG8_MMA(ai, bj, At, Bt) do { __builtin_amdgcn_s_setprio(1); _Pragma("unroll") for (int m = 0; m < 4; ++m) _Pragma("unroll") for (int n = 0; n < 2; ++n) _Pragma("unroll") for (int k = 0; k < 2; ++k) \
        acc[ai][bj][m][n] = __builtin_amdgcn_mfma_f32_16x16x32_bf16(Bt[n][k], At[m][k], acc[ai][bj][m][n], 0, 0, 0); __builtin_amdgcn_s_setprio(0); } while (0)
#define PG8_WAIT_V(n) asm volatile("s_waitcnt vmcnt(" #n ")" ::: "memory")
#define PG8_WAIT_L(n) asm volatile("s_waitcnt lgkmcnt(" #n ")" ::: "memory")
#define PG8_BAR __builtin_amdgcn_s_barrier()
#define PG8_SCHED __builtin_amdgcn_sched_barrier(0)
    typename Sched::Unit cur, nxt; int ui = 0;
    if (!S.next(0, cur)) return;
    f32x4 acc[2][2][4][2];
#pragma unroll
    for (int a = 0; a < 2; ++a)
#pragma unroll
        for (int b = 0; b < 2; ++b)
#pragma unroll
            for (int m = 0; m < 4; ++m)
#pragma unroll
                for (int n = 0; n < 2; ++n) acc[a][b][m][n] = (f32x4){0.f, 0.f, 0.f, 0.f};
    bf16x8 At[4][2], B0[2][2], B1[2][2];
    unsigned cAo[2][2], nAo[2][2];
    const char* cA = Abase;
    if constexpr (GA) S.a_off(cur, Rr, Cc, cAo); else cA = S.a_ptr(cur);
    const char* cB = S.b_ptr(cur);
    if constexpr (SP2) {
        PG8_STAGE(PG8_SB(0, 0), cB, voffB); PG8_STAGE(PG8_SB(0, 1), cB + hstep, voffB); PG8_STAGE_A(PG8_SA(0, 0), cA, 0, cAo); PG8_STAGE_A(PG8_SA(0, 1), cA, 1, cAo);
        if (wr == 1) PG8_BAR;
        PG8_WAIT_V(2); PG8_BAR;
        PG8_STAGE(PG8_SB(1, 0), cB + kstep, voffB); PG8_STAGE_A(PG8_SA(1, 0), cA + kstep, 0, cAo); PG8_STAGE(PG8_SB(1, 1), cB + hstep + kstep, voffB);
        PG8_WAIT_V(6); PG8_BAR;
    } else {
        PG8_STAGE(PG8_SB(0, 0), cB, voffB); PG8_STAGE_A(PG8_SA(0, 0), cA, 0, cAo); PG8_STAGE(PG8_SB(0, 1), cB + hstep, voffB); PG8_STAGE_A(PG8_SA(0, 1), cA, 1, cAo);
        if (wr == 1) PG8_BAR;
        PG8_WAIT_V(4); PG8_BAR;
        PG8_STAGE(PG8_SB(1, 0), cB + kstep, voffB); PG8_STAGE_A(PG8_SA(1, 0), cA + kstep, 0, cAo); PG8_STAGE(PG8_SB(1, 1), cB + hstep + kstep, voffB);
        PG8_WAIT_V(6); PG8_BAR;
    }
    for (;;) {
        const bool has_next = S.next(ui + 1, nxt);
        const char* nB = cB; const char* nA = cA;
        if constexpr (GA) {
#pragma unroll
            for (int h = 0; h < 2; ++h)
#pragma unroll
                for (int i = 0; i < 2; ++i) nAo[h][i] = cAo[h][i];
        }
        if (has_next) { if constexpr (GA) S.a_off(nxt, Rr, Cc, nAo); else nA = S.a_ptr(nxt); nB = S.b_ptr(nxt); }
        for (int t = 0; t < nt; t += 2) {
            const bool last = (t == nt - 2);
            const char* a1 = cA + (size_t)(t + 1) * kstep;
            const char* a2 = last ? nA : cA + (size_t)(t + 2) * kstep; const char* b2 = last ? nB : cB + (size_t)(t + 2) * kstep;
            const char* a3 = a2 + kstep; const char* b3 = b2 + kstep;
            unsigned o2[2][2];
            if constexpr (GA) {
#pragma unroll
                for (int h = 0; h < 2; ++h)
#pragma unroll
                    for (int i = 0; i < 2; ++i) o2[h][i] = last ? nAo[h][i] : cAo[h][i];
            }
            if constexpr (SP2) {
            PG8_LDB(B0, 0, 0); PG8_LDB(B1, 0, 1); PG8_SCHED; PG8_LDA(At, 0, 0); PG8_STAGE_A(PG8_SA(1, 1), a1, 1, cAo);
            PG8_WAIT_V(8); PG8_WAIT_L(0); PG8_BAR; PG8_MMA(0, 0, At, B0); PG8_MMA(0, 1, At, B1); PG8_BAR; PG8_SCHED;
            PG8_LDA(At, 0, 1); PG8_STAGE(PG8_SB(0, 0), b2, voffB); PG8_STAGE(PG8_SB(0, 1), b2 + hstep, voffB); PG8_STAGE_A(PG8_SA(0, 0), a2, 0, o2);
            PG8_WAIT_V(8); PG8_WAIT_L(0); PG8_BAR; PG8_MMA(1, 0, At, B0); PG8_MMA(1, 1, At, B1); PG8_BAR; PG8_SCHED;
            PG8_LDB(B0, 1, 0); PG8_LDB(B1, 1, 1); PG8_SCHED; PG8_LDA(At, 1, 0); PG8_STAGE_A(PG8_SA(0, 1), a2, 1, o2);
            PG8_WAIT_V(8); PG8_WAIT_L(0); PG8_BAR; PG8_MMA(0, 0, At, B0); PG8_MMA(0, 1, At, B1); PG8_BAR; PG8_SCHED;
            PG8_LDA(At, 1, 1); PG8_STAGE(PG8_SB(1, 0), b3, voffB); PG8_STAGE(PG8_SB(1, 1), b3 + hstep, voffB); PG8_STAGE_A(PG8_SA(1, 0), a3, 0, o2);
            PG8_WAIT_V(8); PG8_WAIT_L(0); PG8_BAR; PG8_MMA(1, 0, At, B0); PG8_MMA(1, 1, At, B1); PG8_BAR; PG8_SCHED;
            } else {
            PG8_LDB(B0, 0, 0); PG8_SCHED; PG8_LDA(At, 0, 0); PG8_STAGE_A(PG8_SA(1, 1), a1, 1, cAo);
            PG8_WAIT_L(8); PG8_BAR; PG8_WAIT_L(0); PG8_MMA(0, 0, At, B0); PG8_BAR; PG8_SCHED;
            PG8_LDB(B1, 0, 1); PG8_STAGE(PG8_SB(0, 0), b2, voffB);
            PG8_BAR; PG8_WAIT_L(0); PG8_MMA(0, 1, At, B1); PG8_BAR;
            PG8_LDA(At, 0, 1); PG8_STAGE_A(PG8_SA(0, 0), a2, 0, o2);
            PG8_BAR; PG8_WAIT_L(0); PG8_MMA(1, 0, At, B0); PG8_BAR; PG8_SCHED;
            PG8_STAGE(PG8_SB(0, 1), b2 + hstep, voffB);
            PG8_WAIT_V(6); PG8_BAR; PG8_MMA(1, 1, At, B1); PG8_BAR;
            PG8_LDB(B0, 1, 0); PG8_SCHED; PG8_LDA(At, 1, 0); PG8_STAGE_A(PG8_SA(0, 1), a2, 1, o2);
            PG8_WAIT_L(8); PG8_BAR; PG8_WAIT_L(0); PG8_MMA(0, 0, At, B0); PG8_BAR; PG8_SCHED;
            PG8_LDB(B1, 1, 1); PG8_STAGE(PG8_SB(1, 0), b3, voffB);
            PG8_BAR; PG8_WAIT_L(0); PG8_MMA(0, 1, At, B1); PG8_BAR;
            PG8_LDA(At, 1, 1); PG8_STAGE_A(PG8_SA(1, 0), a3, 0, o2);
            PG8_BAR; PG8_WAIT_L(0); PG8_MMA(1, 0, At, B0); PG8_BAR; PG8_SCHED;
            PG8_STAGE(PG8_SB(1, 1), b3 + hstep, voffB);
            PG8_WAIT_V(6); PG8_BAR; PG8_MMA(1, 1, At, B1); PG8_BAR;
            }
        }
        if constexpr (ALIGN_EPI) { if (wr == 0) PG8_BAR; }
        E(acc, cur, wr, wc, fr, fq);
        if (!has_next) break;
#pragma unroll
        for (int a = 0; a < 2; ++a)
#pragma unroll
            for (int b = 0; b < 2; ++b)
#pragma unroll
                for (int m = 0; m < 4; ++m)
#pragma unroll
                    for (int n = 0; n < 2; ++n) acc[a][b][m][n] = (f32x4){0.f, 0.f, 0.f, 0.f};
        cur = nxt; cB = nB; cA = nA; ++ui;
        if constexpr (GA) {
#pragma unroll
            for (int h = 0; h < 2; ++h)
#pragma unroll
                for (int i = 0; i < 2; ++i) cAo[h][i] = nAo[h][i];
        }
        if constexpr (ALIGN_EPI) { if (wr == 1) PG8_BAR; }
    }
    PG8_WAIT_V(0);
    if constexpr (!ALIGN_EPI) { if (wr == 0) PG8_BAR; }
    PG8_BAR;
#undef PG8_SA
#undef PG8_SB
#undef PG8_STAGE
#undef PG8_STAGE_A
#undef PG8_LDA
#undef PG8_LDB
#undef PG8_MMA
#undef PG8_WAIT_V
#undef PG8_WAIT_L
#undef PG8_BAR
#undef PG8_SCHED
}
}

struct Args { const float* in[22]; float* out; unsigned char* ws; int ph_lo, ph_hi, li, pad; };
struct Ctx {
    LAS unsigned char* lds;
    int tid, lane, wave, G, bid, dry;
    const float *x, *c, *ctx, *c_ctx, *w_ada, *b_ada, *w_in, *conv_w, *conv_b, *gate_b, *head_g, *w_out, *ln1_g, *ln1_b, *w_router, *router_bias, *w_egu, *w_ed, *w_sgu, *w_sd, *ln2_g, *ln2_b;
    float* out; unsigned char* ws;
    DI float* MODP() const { return (float*)(ws + WS_MODP); }
    DI float* MOD() const { return (float*)(ws + WS_TAB + 131072); }
    DI bf16* W1() const { return (bf16*)(ws + WS_TAB); }
    DI bf16* W2() const { return (bf16*)(ws + WS_TAB + 32768); }
    DI bf16* W2I() const { return (bf16*)(ws + WS_TAB + 49152); }
    DI bf16* WRH() const { return (bf16*)(ws + WS_TAB + 262144); }
    DI bf16* WRL() const { return (bf16*)(ws + WS_TAB + 393216); }
    DI f32x2* TW() const { return (f32x2*)(ws + WS_TAB + 65536); }
    DI float* GL() const { return (float*)(ws + WS_GL); }
    DI int* ROWTAB() const { return (int*)(ws + WS_ROWTAB); }
    DI int* EIDX() const { return (int*)(ws + WS_EIDX); }
    DI int* EPOS() const { return (int*)(ws + WS_EPOS); }
    DI float* EGATE() const { return (float*)(ws + WS_EGATE); }
    DI float* SC() const { return (float*)(ws + WS_SC); }
    DI float* NHAT() const { return (float*)(ws + WS_NHAT); }
    DI float* NIN() const { return (float*)(ws + WS_NIN); }
    DI float* MINV() const { return (float*)(ws + WS_MIN); }
    DI bf16* WDT() const { return (bf16*)(ws + WS_WDT); }
    DI bf16* HB() const { return (bf16*)(ws + WS_HB); }
    DI bf16* YB() const { return (bf16*)(ws + WS_YB); }
    DI bf16* WGUT() const { return (bf16*)(ws + WS_WGUT); }
    DI bf16* T() const { return (bf16*)(ws + WS_T); }
    DI bf16* WINT() const { return (bf16*)(ws + WS_WINT); }
    DI bf16* WOUTT() const { return (bf16*)(ws + WS_WOUTT); }
    DI bf16* XN() const { return (bf16*)(ws + WS_XN); }
    DI bf16* MIXIN() const { return (bf16*)(ws + WS_MIXIN); }
    DI bf16* PROJ() const { return (bf16*)(ws + WS_PROJ); }
    DI bf16* FCS() const { return (bf16*)(ws + WS_FCS); }
    DI bf16* QK() const { return (bf16*)(ws + WS_QK); }
    DI bf16* CIN() const { return (bf16*)(ws + WS_CIN); }
    DI bf16* CHAT() const { return (bf16*)(ws + WS_CHAT); }
    DI bf16* X1() const { return (bf16*)(ws + WS_X1); }
    DI bf16* MIXB() const { return (bf16*)(ws + WS_MIXB); }
    DI unsigned* ctl() const { return (unsigned*)(ws + WS_CTL); }
};

DI void p0_router_item(const Ctx& F, int item, LAS float* scr) {
    const int kb = item >> 1, nb = item & 1, k0 = 64 * kb, lane = F.lane;
    float t[32];
#pragma unroll
    for (int i = 0; i < 32; ++i) t[i] = F.w_router[(size_t)(k0 + 2 * i + (lane >> 5)) * 64 + 32 * nb + (lane & 31)];
#pragma unroll
    for (int i = 0; i < 32; ++i) scr[(2 * i + (lane >> 5)) * 33 + (lane & 31)] = t[i];
    LDS_WAIT();
    const int c = lane & 7;
#pragma unroll
    for (int j = 0; j < 4; ++j) { const int n = (lane >> 3) + 8 * j; const LAS float* sp = scr + (8 * c) * 33 + n;
        u32x4 oh; oh.x = pkh2(sp[0 * 33], sp[1 * 33]); oh.y = pkh2(sp[2 * 33], sp[3 * 33]); oh.z = pkh2(sp[4 * 33], sp[5 * 33]); oh.w = pkh2(sp[6 * 33], sp[7 * 33]);
        *(u32x4*)(F.WRH() + (size_t)(32 * nb + n) * 1024 + k0 + 8 * c) = oh; }
    LDS_WAIT();
}
DI void p0_adaln_item(const Ctx& F, int item, LAS float* scr) {
    const int cg = item % 24, ks = item / 24, lane = F.lane, col = 256 * cg + 4 * lane;
    { const int k = 64 * ks + lane;
#pragma unroll
      for (int r = 0; r < 5; ++r) { const float v = r < 4 ? F.c[r * 1024 + k] : F.c_ctx[k]; scr[lane * 8 + r] = v / (1.0f + expf(-v)); } }
    LDS_WAIT();
    f32x4 acc[5];
#pragma unroll
    for (int r = 0; r < 5; ++r) acc[r] = (f32x4){0.f, 0.f, 0.f, 0.f};
    const float* wp = F.w_ada + (size_t)(64 * ks) * 6144 + col;
#pragma unroll 1
    for (int k0 = 0; k0 < 64; k0 += 32) {
        f32x4 wv[32];
#pragma unroll
        for (int i = 0; i < 32; ++i) wv[i] = __builtin_nontemporal_load((const f32x4*)(wp + (size_t)(k0 + i) * 6144));
#pragma unroll
        for (int i = 0; i < 32; ++i) { const f32x4 s0 = *(const LAS f32x4*)(scr + (k0 + i) * 8); const float s4 = scr[(k0 + i) * 8 + 4];
            acc[0] += wv[i] * s0.x; acc[1] += wv[i] * s0.y; acc[2] += wv[i] * s0.z; acc[3] += wv[i] * s0.w; acc[4] += wv[i] * s4; } }
#pragma unroll
    for (int r = 0; r < 5; ++r) { unsigned long long* p = (unsigned long long*)(F.MODP() + (size_t)(ks * 5 + r) * 6144 + col);
        const f32x2 lo2 = (f32x2){acc[r].x, acc[r].y}, hi2 = (f32x2){acc[r].z, acc[r].w};
        __hip_atomic_store(p, __builtin_bit_cast(unsigned long long, lo2), __ATOMIC_RELAXED, __HIP_MEMORY_SCOPE_AGENT);
        __hip_atomic_store(p + 1, __builtin_bit_cast(unsigned long long, hi2), __ATOMIC_RELAXED, __HIP_MEMORY_SCOPE_AGENT); }
    asm volatile("s_waitcnt vmcnt(0)" ::: "memory");
    unsigned old = 0u; if (lane == 0) old = __hip_atomic_fetch_add(F.ctl() + CW_ADA + 16 * cg, 1u, __ATOMIC_RELAXED, __HIP_MEMORY_SCOPE_AGENT);
    old = (unsigned)__builtin_amdgcn_readfirstlane((int)old);
    if (old == 15u) {
#pragma unroll 1
        for (int r = 0; r < 5; ++r) { unsigned long long pa[16], pb[16];
#pragma unroll
            for (int q = 0; q < 16; ++q) { const unsigned long long* p = (const unsigned long long*)(F.MODP() + (size_t)(q * 5 + r) * 6144 + col);
                pa[q] = __hip_atomic_load(p, __ATOMIC_RELAXED, __HIP_MEMORY_SCOPE_AGENT); pb[q] = __hip_atomic_load(p + 1, __ATOMIC_RELAXED, __HIP_MEMORY_SCOPE_AGENT); }
            f32x4 sum = *(const f32x4*)(F.b_ada + col);
#pragma unroll
            for (int q = 0; q < 16; ++q) { const f32x2 a = __builtin_bit_cast(f32x2, pa[q]), b = __builtin_bit_cast(f32x2, pb[q]); sum.x += a.x; sum.y += a.y; sum.z += b.x; sum.w += b.y; }
            unsigned long long* mp = (unsigned long long*)(F.MOD() + r * 6144 + col); const f32x2 lo2 = (f32x2){sum.x, sum.y}, hi2 = (f32x2){sum.z, sum.w};
            __hip_atomic_store(mp, __builtin_bit_cast(unsigned long long, lo2), __ATOMIC_RELAXED, __HIP_MEMORY_SCOPE_AGENT);
            __hip_atomic_store(mp + 1, __builtin_bit_cast(unsigned long long, hi2), __ATOMIC_RELAXED, __HIP_MEMORY_SCOPE_AGENT); }
        asm volatile("s_waitcnt vmcnt(0)" ::: "memory");
        if (lane == 0) __hip_atomic_fetch_add(F.ctl() + CW_MODDONE, 1u, __ATOMIC_RELAXED, __HIP_MEMORY_SCOPE_AGENT); }
    LDS_WAIT();
}
DI void p0_fold_item(const Ctx& F, int item, LAS float* scr) {
    const int g = item & 7, kb = item >> 3, lane = F.lane, k0 = 32 * kb;
    { float t[32];
#pragma unroll
      for (int i = 0; i < 32; ++i) t[i] = F.w_in[(size_t)(k0 + i) * DINP + 2064 + 64 * g + lane];
#pragma unroll
      for (int i = 0; i < 32; ++i) scr[i * 68 + lane] = t[i]; }
    LDS_WAIT();
    const bool isc = lane <= 32; const int jf = isc ? lane : lane - 32;
    float acc[32];
#pragma unroll
    for (int i = 0; i < 32; ++i) acc[i] = 0.f;
#pragma unroll 1
    for (int ch = 0; ch < 4; ++ch) {
        float tb[16];
#pragma unroll
        for (int c = 0; c < 16; ++c) { const float a = (float)((jf * (16 * ch + c)) & 63) * (1.0f / 64.0f); tb[c] = isc ? __builtin_amdgcn_cosf(a) : __builtin_amdgcn_sinf(a); }
#pragma unroll
        for (int i = 0; i < 32; ++i) {
#pragma unroll
            for (int c4 = 0; c4 < 4; ++c4) { const f32x4 xv = *(const LAS f32x4*)(scr + i * 68 + 16 * ch + 4 * c4);
                acc[i] += (xv.x * tb[4 * c4] + xv.y * tb[4 * c4 + 1]) + (xv.z * tb[4 * c4 + 2] + xv.w * tb[4 * c4 + 3]); }
            if ((i & 3) == 3) asm volatile("" ::: "memory"); }
    }
    bf16* dp = F.WINT() + (size_t)(2048 + 64 * g + lane) * 1024 + k0;
#pragma unroll
    for (int i8 = 0; i8 < 4; ++i8) { u32x4 o; o.x = pk2(acc[8 * i8], acc[8 * i8 + 1]); o.y = pk2(acc[8 * i8 + 2], acc[8 * i8 + 3]); o.z = pk2(acc[8 * i8 + 4], acc[8 * i8 + 5]); o.w = pk2(acc[8 * i8 + 6], acc[8 * i8 + 7]);
        *(u32x4*)(dp + 8 * i8) = o; }
    LDS_WAIT();
}
DI void p0_tables_item(const Ctx& F, int item) {
    const int idx = item * 64 + F.lane;
    if (idx < 16384) { const int m = idx >> 7, k = idx & 127, ri = m >> 6, k1 = m & 63, cs = k >> 6, n1 = k & 63;
        const float a = (float)((k1 * n1) & 63) * (1.0f / 64.0f), cv = __builtin_amdgcn_cosf(a), sv = __builtin_amdgcn_sinf(a);
        const float v = ri == 0 ? (cs == 0 ? cv : -sv) : (cs == 0 ? -sv : -cv); F.W1()[idx] = (bf16)f2bf(v); }
    else if (idx < 24576) { const int j = idx - 16384, k2 = j >> 7, k = j & 127, ri = k >> 6, n2 = k & 63;
        const float a = (float)((k2 * n2) & 63) * (1.0f / 64.0f), cv = __builtin_amdgcn_cosf(a), sv = __builtin_amdgcn_sinf(a);
        F.W2()[j] = (bf16)f2bf(ri == 0 ? cv : sv); F.W2I()[j] = (bf16)f2bf(ri == 0 ? -sv : cv); }
    else { const int j = idx - 24576; const float a = (float)j * (6.283185307179586f / 4096.0f); F.TW()[j] = (f32x2){cosf(a), sinf(a)}; }
}
struct TDesc { const float* src; bf16* dst; int ldw, K; };
constexpr int T_IN = 16 * 64, T_OUT = 16 * 32, T_GU = 65 * 256, T_DN = 65 * 128, T_ALL = T_IN + T_OUT + T_GU + T_DN;
constexpr int P2_BUSY = 664 - 512;
constexpr int T_LATE = (256 - P2_BUSY) * 8 * 10, T_EARLY = T_ALL - T_LATE;
DI void p0_tdesc(const Ctx& F, int r, int lane, TDesc& d) {
    const float* W; int ldw, col0, K, k0; bf16* dst;
    if (r < T_IN) { const int kb = r >> 6, nb = r & 63; W = F.w_in; ldw = DINP; col0 = 32 * nb; K = 1024; k0 = 64 * kb; dst = F.WINT() + (size_t)(32 * nb) * 1024; }
    else if (r < T_IN + T_OUT) { const int q = r - T_IN, kb = q >> 5, nb = q & 31; W = F.w_out; ldw = 1024; col0 = 32 * nb; K = 1024; k0 = 64 * kb; dst = F.WOUTT() + (size_t)(32 * nb) * 1024; }
    else if (r < T_IN + T_OUT + T_GU) { const int q0 = r - T_IN - T_OUT, e = q0 >> 8, q = q0 & 255, kb = q >> 4, nb = q & 15;
        W = e < 64 ? F.w_egu + (size_t)e * 1024 * 512 : F.w_sgu; ldw = 512; col0 = 32 * nb; K = 1024; k0 = 64 * kb;
        const int bj = col0 >> 8, hid = col0 & 255, drow = 256 * (hid >> 7) + 128 * bj + (hid & 127); dst = F.WGUT() + ((size_t)e * 512 + drow) * 1024; }
    else { const int q0 = r - T_IN - T_OUT - T_GU, e = q0 >> 7, q = q0 & 127, kb = q >> 5, nb = q & 31;
        W = e < 64 ? F.w_ed + (size_t)e * 256 * 1024 : F.w_sd; ldw = 1024; col0 = 32 * nb; K = 256; k0 = 64 * kb; dst = F.WDT() + ((size_t)e * 1024 + 32 * nb) * 256; }
    d.src = W + (size_t)(k0 + (lane >> 5)) * ldw + col0 + (lane & 31); d.dst = dst + k0; d.ldw = ldw; d.K = K;
}
DI void p0_tload(const TDesc& d, float (&t)[32]) {
#pragma unroll
    for (int i = 0; i < 32; ++i) t[i] = __builtin_nontemporal_load(d.src + (size_t)(2 * i) * d.ldw);
}
DI void p0_tstore(const TDesc& d, const float (&t)[32], LAS float* scr, int lane) {
#pragma unroll
    for (int i = 0; i < 32; ++i) scr[(2 * i + (lane >> 5)) * 33 + (lane & 31)] = t[i];
    LDS_WAIT();
    const int c = lane & 7;
#pragma unroll
    for (int j = 0; j < 4; ++j) { const int n = (lane >> 3) + 8 * j; const LAS float* s = scr + (8 * c) * 33 + n;
        u32x4 o; o.x = pk2(s[0 * 33], s[1 * 33]); o.y = pk2(s[2 * 33], s[3 * 33]); o.z = pk2(s[4 * 33], s[5 * 33]); o.w = pk2(s[6 * 33], s[7 * 33]);
        *(u32x4*)(d.dst + (size_t)n * d.K + 8 * c) = o; }
    LDS_WAIT();
}
DI void p0_transposes(const Ctx& F, LAS float* scr, int first, int stride, int end) {
    int it = first; TDesc dA, dB; float tA[32], tB[32];
    bool vA = it < end; if (vA) { p0_tdesc(F, it, F.lane, dA); p0_tload(dA, tA); }
    while (vA) {
        const int n1 = it + stride; const bool vB = n1 < end; if (vB) { p0_tdesc(F, n1, F.lane, dB); p0_tload(dB, tB); }
        p0_tstore(dA, tA, scr, F.lane);
        if (!vB) break;
        const int n2 = n1 + stride; vA = n2 < end; if (vA) { p0_tdesc(F, n2, F.lane, dA); p0_tload(dA, tA); }
        p0_tstore(dB, tB, scr, F.lane);
        it = n2;
    }
}
DI void p0_prologue(const Ctx& F) {
    LAS float* scr = (LAS float*)(F.lds + F.wave * 17408);
    const int gw = F.bid * 8 + F.wave, NGW = F.G * 8;
    constexpr int I_ADA = 384, I_FOLD = 256, I_TAB = 448, I_RT = 32, NSPEC = I_FOLD + I_ADA + I_TAB + I_RT;
    for (int it = gw; it < NSPEC; it += NGW) {
        int r = it;
        if (r < I_FOLD) { p0_fold_item(F, r, scr); continue; } r -= I_FOLD;
        if (r < I_ADA) { p0_adaln_item(F, r, scr); continue; } r -= I_ADA;
        if (r < I_TAB) { p0_tables_item(F, r); continue; } r -= I_TAB;
        p0_router_item(F, r, scr);
    }
    p0_transposes(F, scr, gw, NGW, (F.G == 256 && MK_N_LAUNCHES == 1) ? T_EARLY : T_ALL);
}

DI void p1_lnmod(const Ctx& F) {
    LAS float* modL = (LAS float*)F.lds;
    LAS bf16* tH = (LAS bf16*)(F.lds + 40960);
    LAS bf16* tLo = (LAS bf16*)(F.lds + 73984);
    LAS float* PL = (LAS float*)(F.lds + 107008);
    const int lane = F.lane, w = F.wave, tid = F.tid, fr = lane & 15, fq = lane >> 4;
    __syncthreads();
    bf16x8 wbh[4], wbl[4];
#pragma unroll
    for (int kk = 0; kk < 4; ++kk) { unsigned hi[8], lo[8];
#pragma unroll
        for (int j = 0; j < 8; ++j) { const float x = F.w_in[(size_t)(128 * w + 32 * kk + 8 * fq + j) * DINP + 2048 + fr]; hi[j] = f2bf(x); lo[j] = f2bf(x - bf2f(hi[j])); }
        u32x4 oh, ol; oh.x = hi[0] | (hi[1] << 16); oh.y = hi[2] | (hi[3] << 16); oh.z = hi[4] | (hi[5] << 16); oh.w = hi[6] | (hi[7] << 16);
        ol.x = lo[0] | (lo[1] << 16); ol.y = lo[2] | (lo[3] << 16); ol.z = lo[4] | (lo[5] << 16); ol.w = lo[6] | (lo[7] << 16);
        wbh[kk] = __builtin_bit_cast(bf16x8, oh); wbl[kk] = __builtin_bit_cast(bf16x8, ol); }
    if (MK_N_LAUNCHES == 1) {
        if (tid == 0) { unsigned sp = 0; while (__hip_atomic_load(F.ctl() + CW_MODDONE, __ATOMIC_RELAXED, __HIP_MEMORY_SCOPE_AGENT) < 24u && ++sp < (1u << 22)) __builtin_amdgcn_s_sleep(2); }
        __syncthreads(); }
    for (int i = tid; i < 5 * 2048; i += 512) modL[i] = __builtin_bit_cast(float, __hip_atomic_load((unsigned*)F.MOD() + (i >> 11) * 6144 + (i & 2047), __ATOMIC_RELAXED, __HIP_MEMORY_SCOPE_AGENT));
    __syncthreads();
    for (int g16 = F.bid; g16 < MALL / 16; g16 += F.G) {
        const int row0 = 16 * g16 + 2 * w;
        const int mr = row0 < MX ? (row0 >> 12) : 4;
        f32x4 xa[2][4];
#pragma unroll
        for (int rr = 0; rr < 2; ++rr) { const int row = row0 + rr; const float* xr = row < MX ? F.x + (size_t)row * 1024 : F.ctx + (size_t)(row - MX) * 1024;
#pragma unroll
            for (int m = 0; m < 4; ++m) xa[rr][m] = __builtin_nontemporal_load((const f32x4*)(xr + 256 * m + 4 * lane)); }
#pragma unroll
        for (int rr = 0; rr < 2; ++rr) {
            const int lr = 2 * w + rr, row = row0 + rr;
            f32x4 v[4]; float s = 0.f;
#pragma unroll
            for (int m = 0; m < 4; ++m) { v[m] = xa[rr][m]; s += (v[m].x + v[m].y) + (v[m].z + v[m].w); }
            const float mean = wave_sum(s) * (1.0f / 1024.0f); float s2 = 0.f;
#pragma unroll
            for (int m = 0; m < 4; ++m) { v[m] = v[m] - mean; s2 += (v[m].x * v[m].x + v[m].y * v[m].y) + (v[m].z * v[m].z + v[m].w * v[m].w); }
            const float rstd = 1.0f / sqrtf(wave_sum(s2) * (1.0f / 1024.0f) + LN_EPS);
            bf16* xo = F.XN() + (size_t)row * 1024;
#pragma unroll
            for (int m = 0; m < 4; ++m) { const int k = 256 * m + 4 * lane; const f32x4 sh = *(const LAS f32x4*)(modL + mr * 2048 + k), sc = *(const LAS f32x4*)(modL + mr * 2048 + 1024 + k);
                const f32x4 t = v[m] * rstd * (sc + 1.0f) + sh;
                u32x2 oh; oh.x = pk2(t.x, t.y); oh.y = pk2(t.z, t.w); *(u32x2*)(xo + k) = oh; *(LAS u32x2*)(tH + lr * 1032 + k) = oh;
                u32x2 ol; ol.x = pk2(t.x - bflo(oh.x), t.y - bfhi(oh.x)); ol.y = pk2(t.z - bflo(oh.y), t.w - bfhi(oh.y)); *(LAS u32x2*)(tLo + lr * 1032 + k) = ol; }
        }
        __syncthreads();
        {
            f32x4 a0 = (f32x4){0.f, 0.f, 0.f, 0.f}, a1 = a0, a2 = a0;
#pragma unroll
            for (int kk = 0; kk < 4; ++kk) { const bf16x8 ah = *(const LAS bf16x8*)(tH + fr * 1032 + 128 * w + 32 * kk + 8 * fq), al = *(const LAS bf16x8*)(tLo + fr * 1032 + 128 * w + 32 * kk + 8 * fq);
                a0 = MFMA16(ah, wbh[kk], a0); a1 = MFMA16(ah, wbl[kk], a1); a2 = MFMA16(al, wbh[kk], a2); }
#pragma unroll
            for (int r = 0; r < 4; ++r) PL[(w * 16 + 4 * fq + r) * 16 + fr] = a0[r] + (a1[r] + a2[r]);
        }
        __syncthreads();
        if (tid < 256) { const int lr = tid >> 4, g = tid & 15; float pre = F.gate_b[g];
#pragma unroll
            for (int ww = 0; ww < 8; ++ww) pre += PL[(ww * 16 + lr) * 16 + g];
            F.GL()[(size_t)(16 * g16 + lr) * 16 + g] = ((g >> 2) & 1) ? logsigf(pre) : pre; }
        __syncthreads();
    }
}

struct ProjOrder {
    struct Unit { int pm, pn; }; static constexpr bool GATHER = false;
    int G, c; const bf16* WinT; const bf16* A;
    DI bool next(int i, Unit& u) const { const int L = i * G + c; if (L >= 664) return false;
        if (L < 640) pg8::static_tile(L, 64, 10, u.pm, u.pn); else { const int j = L - 640; u.pm = 64 + j / 6; u.pn = j % 6; } return true; }
    DI const char* a_ptr(const Unit& u) const { return (const char*)(A + (size_t)u.pm * 256 * 1024); }
    DI const char* b_ptr(const Unit& u) const { return (const char*)(WinT + (size_t)u.pn * 256 * 1024); }
};
struct EpiProj {
    static constexpr bool PERM = true;
    bf16* PROJ; bf16* FCS;
    DI void operator()(const f32x4 (&acc)[2][2][4][2], const ProjOrder::Unit& u, int wr, int wc, int fr, int fq) const {
        asm volatile("s_nop 15\n\ts_nop 3" ::: "memory");
        const int row0 = u.pm * 256 + wr * 64 + fr;
        if (u.pn < 8) {
            const int col0 = u.pn * 256 + wc * 32 + 8 * fq;
#pragma unroll
            for (int ai = 0; ai < 2; ++ai)
#pragma unroll
                for (int m = 0; m < 4; ++m) { bf16* rowp = PROJ + (size_t)(row0 + ai * 128 + m * 16) * 2048 + col0;
#pragma unroll
                    for (int bj = 0; bj < 2; ++bj) { const f32x4 v0 = acc[ai][bj][m][0], v1 = acc[ai][bj][m][1];
                        u32x4 w; w.x = pg8::cvt_pk_bf16(v0[0], v0[1]); w.y = pg8::cvt_pk_bf16(v0[2], v0[3]); w.z = pg8::cvt_pk_bf16(v1[0], v1[1]); w.w = pg8::cvt_pk_bf16(v1[2], v1[3]);
                        *(u32x4*)(rowp + bj * 128) = w; } }
        } else {
            const int sc0 = (u.pn - 8) * 256 + wc * 32 + 8 * fq;
#pragma unroll
            for (int ai = 0; ai < 2; ++ai)
#pragma unroll
                for (int m = 0; m < 4; ++m) { const int row = row0 + ai * 128 + m * 16, b = row >> 12, n = row & 4095;
#pragma unroll
                    for (int bj = 0; bj < 2; ++bj) { const int sc = sc0 + bj * 128, g = sc >> 6, sl = sc & 63, part = sl >> 5, cb = 8 * g + ((sl & 31) >> 2); const f32x4 v0 = acc[ai][bj][m][0], v1 = acc[ai][bj][m][1];
                        bf16* p = FCS + ((size_t)((b * 2 + part) * 64 + cb) * 4096 + n) * 4;
                        u32x2 w0, w1; w0.x = pg8::cvt_pk_bf16(v0[0], v0[1]); w0.y = pg8::cvt_pk_bf16(v0[2], v0[3]); w1.x = pg8::cvt_pk_bf16(v1[0], v1[1]); w1.y = pg8::cvt_pk_bf16(v1[2], v1[3]);
                        *(u32x2*)p = w0; *(u32x2*)(p + (size_t)4096 * 4) = w1; } }
        }
    }
};

DI void conv_fma(float (&acc)[8], const float (&w)[8], const u32x4 v) {
    acc[0] += w[0] * bflo(v.x); acc[1] += w[1] * bfhi(v.x); acc[2] += w[2] * bflo(v.y); acc[3] += w[3] * bfhi(v.y);
    acc[4] += w[4] * bflo(v.z); acc[5] += w[5] * bfhi(v.z); acc[6] += w[6] * bflo(v.w); acc[7] += w[7] * bfhi(v.w); }
DI void p3_conv(const Ctx& F) {
    const int cg = F.tid & 127, sub = F.tid >> 7;
    float w[9][8], bias[8];
#pragma unroll
    for (int t = 0; t < 9; ++t) { const f32x4 a = *(const f32x4*)(F.conv_w + t * 1024 + 8 * cg), b = *(const f32x4*)(F.conv_w + t * 1024 + 8 * cg + 4);
        w[t][0] = a.x; w[t][1] = a.y; w[t][2] = a.z; w[t][3] = a.w; w[t][4] = b.x; w[t][5] = b.y; w[t][6] = b.z; w[t][7] = b.w; }
    { const f32x4 a = *(const f32x4*)(F.conv_b + 8 * cg), b = *(const f32x4*)(F.conv_b + 8 * cg + 4);
      bias[0] = a.x; bias[1] = a.y; bias[2] = a.z; bias[3] = a.w; bias[4] = b.x; bias[5] = b.y; bias[6] = b.z; bias[7] = b.w; }
    const float osc = cg >= 64 ? 0.08838834764831845f : 1.0f;
    const u32x4 zero = (u32x4){0u, 0u, 0u, 0u};
    for (int gi = F.bid; gi < NB * 64; gi += F.G) {
        const int gr = (F.G == 256) ? ((gi & 7) * 32 + (gi >> 3)) : gi;
        const int r = gr & 63, base = (gr >> 6) * 4096, c0 = 16 * sub;
        const bool up = r > 0, dn = r < 63;
        const bf16* pm = F.PROJ() + (size_t)(base + r * 64) * 2048 + 8 * cg;
        u32x4 L[3], M[3], Rt[3];
        if (c0 > 0) { L[0] = up ? *(const u32x4*)(pm + (long)(c0 - 1 - 64) * 2048) : zero; L[1] = *(const u32x4*)(pm + (long)(c0 - 1) * 2048); L[2] = dn ? *(const u32x4*)(pm + (long)(c0 - 1 + 64) * 2048) : zero; }
        else { L[0] = zero; L[1] = zero; L[2] = zero; }
        M[0] = up ? *(const u32x4*)(pm + (long)(c0 - 64) * 2048) : zero; M[1] = *(const u32x4*)(pm + (long)c0 * 2048); M[2] = dn ? *(const u32x4*)(pm + (long)(c0 + 64) * 2048) : zero;
#pragma unroll 2
        for (int i = 0; i < 16; ++i) { const int c = c0 + i;
            if (c < 63) { Rt[0] = up ? *(const u32x4*)(pm + (long)(c + 1 - 64) * 2048) : zero; Rt[1] = *(const u32x4*)(pm + (long)(c + 1) * 2048); Rt[2] = dn ? *(const u32x4*)(pm + (long)(c + 1 + 64) * 2048) : zero; }
            else { Rt[0] = zero; Rt[1] = zero; Rt[2] = zero; }
            float acc[8];
#pragma unroll
            for (int j = 0; j < 8; ++j) acc[j] = bias[j];
#pragma unroll
            for (int a = 0; a < 3; ++a) { conv_fma(acc, w[a * 3 + 0], L[a]); conv_fma(acc, w[a * 3 + 1], M[a]); conv_fma(acc, w[a * 3 + 2], Rt[a]); }
            u32x4 o; o.x = pk2(siluf(acc[0]) * osc, siluf(acc[1]) * osc); o.y = pk2(siluf(acc[2]) * osc, siluf(acc[3]) * osc);
            o.z = pk2(siluf(acc[4]) * osc, siluf(acc[5]) * osc); o.w = pk2(siluf(acc[6]) * osc, siluf(acc[7]) * osc);
            *(u32x4*)(F.QK() + (size_t)(base + r * 64 + c) * 1024 + 8 * cg) = o;
#pragma unroll
            for (int a = 0; a < 3; ++a) { L[a] = M[a]; M[a] = Rt[a]; } }
    }
    for (int it = F.bid * 4 + sub; it < MC; it += F.G * 4) {
        const int base = MX + (it & ~255), n = it & 255;
        float acc[8];
#pragma unroll
        for (int j = 0; j < 8; ++j) acc[j] = bias[j];
#pragma unroll
        for (int b = 0; b < 3; ++b) { const int nn = n + b - 1; if (nn >= 0 && nn < 256) conv_fma(acc, w[3 + b], *(const u32x4*)(F.PROJ() + (size_t)(base + nn) * 2048 + 8 * cg)); }
        u32x4 o; o.x = pk2(siluf(acc[0]) * osc, siluf(acc[1]) * osc); o.y = pk2(siluf(acc[2]) * osc, siluf(acc[3]) * osc);
        o.z = pk2(siluf(acc[4]) * osc, siluf(acc[5]) * osc); o.w = pk2(siluf(acc[6]) * osc, siluf(acc[7]) * osc);
        *(u32x4*)(F.QK() + (size_t)(MX + it) * 1024 + 8 * cg) = o;
    }
}

DI int chunk_row0(int b, int cc) { return cc < 2 ? MX + b * 256 + cc * 128 : b * 4096 + (cc - 2) * 128; }
constexpr int TS = 288;
DI void p4_item(const Ctx& F, int it) {
    const int seq = it / NCH, cc = it % NCH, dir = seq & 1, h = (seq >> 1) & 3, b = seq >> 3, R0 = chunk_row0(b, cc);
    LAS unsigned char* KW = F.lds;
    LAS unsigned char* VV = F.lds + 36864;
    LAS float* wS = (LAS float*)(F.lds + 73728);
    const int lane = F.lane, tid = F.tid;
    u32x4 kv[4], vv[4];
#pragma unroll
    for (int i = 0; i < 4; ++i) { const int idx = tid + 512 * i, row = idx >> 4, ch = idx & 15;
        kv[i] = *(const u32x4*)(F.QK() + (size_t)(R0 + row) * 1024 + 512 + h * 128 + 8 * ch); vv[i] = *(const u32x4*)(F.PROJ() + (size_t)(R0 + row) * 2048 + 1024 + h * 128 + 8 * ch); }
    if (F.wave == 0) {
        const int p0 = 2 * lane, p1 = p0 + 1, pos0 = dir ? 127 - p0 : p0, pos1 = dir ? 127 - p1 : p1;
        const float lf0 = F.GL()[(size_t)(R0 + pos0) * 16 + dir * 8 + 4 + h], lf1 = F.GL()[(size_t)(R0 + pos1) * 16 + dir * 8 + 4 + h];
        const float li0 = F.GL()[(size_t)(R0 + pos0) * 16 + dir * 8 + h], li1 = F.GL()[(size_t)(R0 + pos1) * 16 + dir * 8 + h];
        const float s = lf0 + lf1, incl = scan_add(s, lane), excl = incl - s, b0 = excl + lf0, b1 = b0 + lf1, a0 = li0 - b0, a1 = li1 - b1;
        const float A = wave_max(fmaxf(a0, a1)), total = __shfl(incl, 63);
        wS[pos0] = __expf(a0 - A); wS[pos1] = __expf(a1 - A);
        if (lane == 0) { F.SC()[it * 2] = A; F.SC()[it * 2 + 1] = total; }
    }
    __syncthreads();
#pragma unroll
    for (int i = 0; i < 4; ++i) { const int idx = tid + 512 * i, row = idx >> 4, ch = idx & 15; const float w = wS[row];
        u32x4 o; o.x = pk2(bflo(kv[i].x) * w, bfhi(kv[i].x) * w); o.y = pk2(bflo(kv[i].y) * w, bfhi(kv[i].y) * w); o.z = pk2(bflo(kv[i].z) * w, bfhi(kv[i].z) * w); o.w = pk2(bflo(kv[i].w) * w, bfhi(kv[i].w) * w);
        *(LAS u32x4*)(KW + row * TS + 16 * ch) = o; *(LAS u32x4*)(VV + row * TS + 16 * ch) = vv[i]; }
    __syncthreads();
    const int fr = lane & 15, fq = lane >> 4, w = F.wave;
    const unsigned ab = tr_base<TS, 8>(lds_addr(VV), lane) + 32u * (unsigned)w, bb = tr_base<TS, 8>(lds_addr(KW), lane);
    f32x4 acc[8], accn = (f32x4){0.f, 0.f, 0.f, 0.f};
#pragma unroll
    for (int nt = 0; nt < 8; ++nt) acc[nt] = (f32x4){0.f, 0.f, 0.f, 0.f};
    bf16x8 ones; { const u32x4 o1 = (u32x4){0x3f803f80u, 0x3f803f80u, 0x3f803f80u, 0x3f803f80u}; ones = __builtin_bit_cast(bf16x8, o1); }
#define P4_KK(kk) { const bf16x8 a = tr2<(kk) * 32 * TS, (kk) * 32 * TS + 4 * TS>(ab); bf16x8 bfr[8]; tr2x8<(kk) * 32 * TS, 4 * TS>(bb, bfr); \
        _Pragma("unroll") for (int nt = 0; nt < 8; ++nt) acc[nt] = MFMA16(bfr[nt], a, acc[nt]); \
        const bf16x8 bw = tr2<(kk) * 32 * TS, (kk) * 32 * TS + 4 * TS>(bb + 32u * (unsigned)w); accn = MFMA16(ones, bw, accn); }
    P4_KK(0) P4_KK(1) P4_KK(2) P4_KK(3)
#undef P4_KK
    bf16* co = F.CHAT() + (size_t)it * 16384;
#pragma unroll
    for (int nt = 0; nt < 8; ++nt) {
        const float c0 = __builtin_amdgcn_fmed3f(acc[nt][0], -3.0e38f, 3.0e38f), c1 = __builtin_amdgcn_fmed3f(acc[nt][1], -3.0e38f, 3.0e38f), c2 = __builtin_amdgcn_fmed3f(acc[nt][2], -3.0e38f, 3.0e38f), c3 = __builtin_amdgcn_fmed3f(acc[nt][3], -3.0e38f, 3.0e38f);
        u32x2 o; o.x = pk2(c0, c1); o.y = pk2(c2, c3); *(u32x2*)(co + (16 * w + fr) * 128 + 16 * nt + 4 * fq) = o; }
    if (fq == 0) F.NHAT()[(size_t)it * 128 + 16 * w + fr] = accn[0];
    __syncthreads();
}

DI int proc_chunk(int dir, int p) { return dir == 0 ? p : (p < 2 ? 1 - p : 35 - p); }
DI void p5_scan(const Ctx& F) {
    LAS float* f1S = (LAS float*)F.lds;
    LAS float* f2S = f1S + 64;
    LAS int* itS = (LAS int*)(f1S + 128);
    for (int u = F.bid; u < 32 * 8; u += F.G) {
        const int seq = u >> 3, blk = u & 7, dir = seq & 1;
        if (F.tid == 0) { float m = 0.f;
            for (int p = 0; p < NCH; ++p) { const int it = seq * NCH + proc_chunk(dir, p); const float A = F.SC()[it * 2], bl = F.SC()[it * 2 + 1], Ml = fmaxf(m, A);
                f1S[p] = __expf(m - Ml); f2S[p] = __expf(A - Ml); itS[p] = it; if (blk == 0 && p >= 2) F.MINV()[seq * 32 + p - 2] = m; m = bl + Ml; } }
        __syncthreads();
        const int qd = blk * 512 + F.tid;
        f32x4 C = (f32x4){0.f, 0.f, 0.f, 0.f};
        { f32x4 ch[2];
#pragma unroll
          for (int q = 0; q < 2; ++q) { const u32x2 cw = *(const u32x2*)(F.CHAT() + (size_t)itS[q] * 16384 + qd * 4); ch[q].x = bflo(cw.x); ch[q].y = bfhi(cw.x); ch[q].z = bflo(cw.y); ch[q].w = bfhi(cw.y); }
#pragma unroll
          for (int q = 0; q < 2; ++q) C = C * f1S[q] + ch[q] * f2S[q]; }
#pragma unroll 1
        for (int p0 = 2; p0 < NCH; p0 += 8) {
            u32x2 cw[8]; f32x4 ch[8];
#pragma unroll
            for (int q = 0; q < 8; ++q) cw[q] = *(const u32x2*)(F.CHAT() + (size_t)itS[p0 + q] * 16384 + qd * 4);
#pragma unroll
            for (int q = 0; q < 8; ++q) { ch[q].x = bflo(cw[q].x); ch[q].y = bfhi(cw[q].x); ch[q].z = bflo(cw[q].y); ch[q].w = bfhi(cw[q].y); }
#pragma unroll
            for (int q = 0; q < 8; ++q) { u32x2 o; o.x = pk2(C.x, C.y); o.y = pk2(C.z, C.w); *(u32x2*)(F.CIN() + ((size_t)(seq * 32 + p0 + q - 2) * 16384 + qd * 4)) = o;
                C = C * f1S[p0 + q] + ch[q] * f2S[p0 + q]; }
        }
        if (blk == 0 && F.tid < 128) { float n = 0.f;
#pragma unroll 1
            for (int p = 0; p < NCH; ++p) { if (p >= 2) F.NIN()[(size_t)(seq * 32 + p - 2) * 128 + F.tid] = n; n = n * f1S[p] + F.NHAT()[(size_t)itS[p] * 128 + F.tid] * f2S[p]; } }
        __syncthreads();
    }
}

DI void p6_mlstm_item(const Ctx& F, int it) {
    const int c = it & 31, h = (it >> 5) & 3, b = it >> 7, R0 = b * 4096 + c * 128;
    LAS unsigned char* Q = F.lds;
    LAS unsigned char* Kx = F.lds + 36864;
    LAS unsigned char* VV = F.lds + 73728;
    LAS float* aS = (LAS float*)(F.lds + 110592);
    LAS float* MS = aS + 256; LAS float* inS = aS + 512; LAS float* flS = aS + 768; LAS float* qnS = aS + 1024; LAS float* nS = aS + 1280;
    LAS float* OT = (LAS float*)F.lds;
    const int lane = F.lane, tid = F.tid, w = F.wave, fr = lane & 15, fq = lane >> 4;
    const int seq0 = (b * 4 + h) * 2, j0 = c, j1 = 31 - c;
    u32x4 lq[4], lk[4], lv[4];
#pragma unroll
    for (int i = 0; i < 4; ++i) { const int idx = tid + 512 * i, row = idx >> 4, ch = idx & 15;
        lq[i] = *(const u32x4*)(F.QK() + (size_t)(R0 + row) * 1024 + h * 128 + 8 * ch); lk[i] = *(const u32x4*)(F.QK() + (size_t)(R0 + row) * 1024 + 512 + h * 128 + 8 * ch);
        lv[i] = *(const u32x4*)(F.PROJ() + (size_t)(R0 + row) * 2048 + 1024 + h * 128 + 8 * ch); }
    if (w < 2) {
        const int dir = w, seq = seq0 + dir, j = dir ? j1 : j0; const float m_in = F.MINV()[seq * 32 + j];
        const int p0 = 2 * lane, p1 = p0 + 1, pos0 = dir ? 127 - p0 : p0, pos1 = dir ? 127 - p1 : p1;
        const float lf0 = F.GL()[(size_t)(R0 + pos0) * 16 + dir * 8 + 4 + h], lf1 = F.GL()[(size_t)(R0 + pos1) * 16 + dir * 8 + 4 + h];
        const float li0 = F.GL()[(size_t)(R0 + pos0) * 16 + dir * 8 + h], li1 = F.GL()[(size_t)(R0 + pos1) * 16 + dir * 8 + h];
        const float s = lf0 + lf1, incl = scan_add(s, lane), excl = incl - s, b0 = excl + lf0, b1 = b0 + lf1, a0 = li0 - b0, a1 = li1 - b1;
        const float c1 = fmaxf(a0, a1), pmi = scan_max(c1, lane); float pme = __shfl_up(pmi, 1); if (lane == 0) pme = -3.0e38f;
        const float M0 = fmaxf(m_in, fmaxf(pme, a0)), M1 = fmaxf(m_in, fmaxf(pme, c1));
        aS[dir * 128 + pos0] = a0; aS[dir * 128 + pos1] = a1; MS[dir * 128 + pos0] = M0; MS[dir * 128 + pos1] = M1;
        inS[dir * 128 + pos0] = __expf(m_in - M0); inS[dir * 128 + pos1] = __expf(m_in - M1);
        flS[dir * 128 + pos0] = __expf(-b0 - M0); flS[dir * 128 + pos1] = __expf(-b1 - M1);
        nS[dir * 128 + lane] = F.NIN()[(size_t)(seq * 32 + j) * 128 + lane]; nS[dir * 128 + 64 + lane] = F.NIN()[(size_t)(seq * 32 + j) * 128 + 64 + lane];
    }
#pragma unroll
    for (int i = 0; i < 4; ++i) { const int idx = tid + 512 * i, row = idx >> 4, ch = idx & 15;
        *(LAS u32x4*)(Q + row * TS + 16 * ch) = lq[i]; *(LAS u32x4*)(Kx + row * TS + 16 * ch) = lk[i]; *(LAS u32x4*)(VV + row * TS + 16 * ch) = lv[i]; }
    u32x4 lc0[4], lc1[4];
    { const bf16* C0 = F.CIN() + (size_t)(seq0 * 32 + j0) * 16384; const bf16* C1 = F.CIN() + (size_t)((seq0 + 1) * 32 + j1) * 16384;
#pragma unroll
      for (int i = 0; i < 4; ++i) { const int idx = tid + 512 * i; lc0[i] = *(const u32x4*)(C0 + idx * 8); lc1[i] = *(const u32x4*)(C1 + idx * 8); } }
    __syncthreads();
    if (tid < 256) { const int dir = tid >> 7, t = tid & 127; float s = 0.f;
#pragma unroll
        for (int j = 0; j < 16; ++j) { const u32x4 q = *(const LAS u32x4*)(Q + t * TS + 16 * j); const LAS float* np = nS + dir * 128 + 8 * j;
            s += bflo(q.x) * np[0] + bfhi(q.x) * np[1] + bflo(q.y) * np[2] + bfhi(q.y) * np[3] + bflo(q.z) * np[4] + bfhi(q.z) * np[5] + bflo(q.w) * np[6] + bfhi(q.w) * np[7]; }
        qnS[dir * 128 + t] = s; }
    bf16x8 qf[4];
#pragma unroll
    for (int kk = 0; kk < 4; ++kk) qf[kk] = *(const LAS bf16x8*)(Q + (16 * w + fr) * TS + 64 * kk + 16 * fq);
    const int tq = 16 * w + fr;
    bf16x8 sf0[4], sf1[4]; float rs0 = 0.f, rs1 = 0.f;
    {
        f32x4 sacc[8];
#pragma unroll
        for (int nt = 0; nt < 8; ++nt) sacc[nt] = (f32x4){0.f, 0.f, 0.f, 0.f};
#pragma unroll
        for (int kk = 0; kk < 4; ++kk)
#pragma unroll
            for (int nt = 0; nt < 8; ++nt) { const bf16x8 kf = *(const LAS bf16x8*)(Kx + (16 * nt + fr) * TS + 64 * kk + 16 * fq); sacc[nt] = MFMA16(kf, qf[kk], sacc[nt]); }
        const float Mt0 = MS[tq], Mt1 = MS[128 + tq];
#pragma unroll
        for (int kk = 0; kk < 4; ++kk) { float p0[8], p1[8];
#pragma unroll
            for (int hf = 0; hf < 2; ++hf) { const int nt = 2 * kk + hf; const f32x4 a40 = *(const LAS f32x4*)(aS + 16 * nt + 4 * fq), a41 = *(const LAS f32x4*)(aS + 128 + 16 * nt + 4 * fq);
#pragma unroll
                for (int r = 0; r < 4; ++r) { const int sk = 16 * nt + 4 * fq + r;
                    const float v0 = (sk <= tq) ? sacc[nt][r] * __expf(a40[r] - Mt0) : 0.f, v1 = (sk >= tq) ? sacc[nt][r] * __expf(a41[r] - Mt1) : 0.f;
                    rs0 += v0; rs1 += v1; p0[4 * hf + r] = v0; p1[4 * hf + r] = v1; } }
            u32x4 pk; pk.x = pk2(p0[0], p0[1]); pk.y = pk2(p0[2], p0[3]); pk.z = pk2(p0[4], p0[5]); pk.w = pk2(p0[6], p0[7]); sf0[kk] = __builtin_bit_cast(bf16x8, pk);
            pk.x = pk2(p1[0], p1[1]); pk.y = pk2(p1[2], p1[3]); pk.z = pk2(p1[4], p1[5]); pk.w = pk2(p1[6], p1[7]); sf1[kk] = __builtin_bit_cast(bf16x8, pk); }
    }
    rs0 += __shfl_xor(rs0, 16); rs0 += __shfl_xor(rs0, 32); rs1 += __shfl_xor(rs1, 16); rs1 += __shfl_xor(rs1, 32);
    __syncthreads();
#pragma unroll
    for (int i = 0; i < 4; ++i) { const int idx = tid + 512 * i, row = idx >> 4, ch = idx & 15; *(LAS u32x4*)(Kx + row * TS + 16 * ch) = lc0[i]; *(LAS u32x4*)(Q + row * TS + 16 * ch) = lc1[i]; }
    u32x4 og[4];
#pragma unroll
    for (int i = 0; i < 4; ++i) { const int cidx = lane + 64 * i; og[i] = *(const u32x4*)(F.PROJ() + (size_t)(R0 + 16 * w + (cidx >> 4)) * 2048 + 1536 + h * 128 + 8 * (cidx & 15)); }
    __syncthreads();
    const unsigned vb = tr_base<TS, 4>(lds_addr(VV), lane);
    f32x4 hs[8];
#pragma unroll
    for (int nt = 0; nt < 8; ++nt) hs[nt] = (f32x4){0.f, 0.f, 0.f, 0.f};
#define P6_HALF(hv, sf, CT) { f32x4 num[4]; \
        _Pragma("unroll") for (int q4 = 0; q4 < 4; ++q4) num[q4] = (f32x4){0.f, 0.f, 0.f, 0.f}; \
        { bf16x8 vf[4]; tr2x4<0 * 32 * TS + 128 * (hv), 16 * TS>(vb, vf); _Pragma("unroll") for (int q4 = 0; q4 < 4; ++q4) num[q4] = MFMA16(sf[0], vf[q4], num[q4]); } \
        { bf16x8 vf[4]; tr2x4<1 * 32 * TS + 128 * (hv), 16 * TS>(vb, vf); _Pragma("unroll") for (int q4 = 0; q4 < 4; ++q4) num[q4] = MFMA16(sf[1], vf[q4], num[q4]); } \
        { bf16x8 vf[4]; tr2x4<2 * 32 * TS + 128 * (hv), 16 * TS>(vb, vf); _Pragma("unroll") for (int q4 = 0; q4 < 4; ++q4) num[q4] = MFMA16(sf[2], vf[q4], num[q4]); } \
        { bf16x8 vf[4]; tr2x4<3 * 32 * TS + 128 * (hv), 16 * TS>(vb, vf); _Pragma("unroll") for (int q4 = 0; q4 < 4; ++q4) num[q4] = MFMA16(sf[3], vf[q4], num[q4]); } \
        _Pragma("unroll") for (int q4 = 0; q4 < 4; ++q4) _Pragma("unroll") for (int r = 0; r < 4; ++r) hs[4 * (hv) + q4][r] += num[q4][r] * inv[r]; \
        _Pragma("unroll") for (int q4 = 0; q4 < 4; ++q4) num[q4] = (f32x4){0.f, 0.f, 0.f, 0.f}; \
        _Pragma("unroll") for (int kk = 0; kk < 4; ++kk) _Pragma("unroll") for (int q4 = 0; q4 < 4; ++q4) { \
            const bf16x8 cf = *(const LAS bf16x8*)((CT) + (16 * (4 * (hv) + q4) + fr) * TS + 64 * kk + 16 * fq); num[q4] = MFMA16(qf[kk], cf, num[q4]); } \
        _Pragma("unroll") for (int q4 = 0; q4 < 4; ++q4) _Pragma("unroll") for (int r = 0; r < 4; ++r) hs[4 * (hv) + q4][r] += num[q4][r] * inter[r]; \
        asm volatile("" ::: "memory"); }
    {   float inter[4], inv[4];
#pragma unroll
        for (int r = 0; r < 4; ++r) { const int t = 16 * w + 4 * fq + r; const float rsr = __shfl(rs0, 4 * fq + r); inter[r] = inS[t];
            const float den = rsr + inter[r] * qnS[t]; inv[r] = 1.0f / fmaxf(fabsf(den), flS[t]); inter[r] *= inv[r]; }
        P6_HALF(0, sf0, Kx) P6_HALF(1, sf0, Kx) }
    {   float inter[4], inv[4];
#pragma unroll
        for (int r = 0; r < 4; ++r) { const int t = 16 * w + 4 * fq + r; const float rsr = __shfl(rs1, 4 * fq + r); inter[r] = inS[128 + t];
            const float den = rsr + inter[r] * qnS[128 + t]; inv[r] = 1.0f / fmaxf(fabsf(den), flS[128 + t]); inter[r] *= inv[r]; }
        P6_HALF(0, sf1, Q) P6_HALF(1, sf1, Q) }
#undef P6_HALF
    __syncthreads();
#pragma unroll
    for (int r = 0; r < 4; ++r) { const int t = 16 * w + 4 * fq + r; float s = 0.f;
#pragma unroll
        for (int nt = 0; nt < 8; ++nt) s += hs[nt][r];
        const float mean = red16(s) * (1.0f / 128.0f); float q2 = 0.f;
#pragma unroll
        for (int nt = 0; nt < 8; ++nt) { const float d = hs[nt][r] - mean; q2 += d * d; }
        const float rstd = 1.0f / sqrtf(red16(q2) * (1.0f / 128.0f) + LN_EPS);
#pragma unroll
        for (int nt = 0; nt < 8; ++nt) OT[t * 132 + 16 * nt + fr] = (hs[nt][r] - mean) * rstd; }
    LDS_WAIT();
#pragma unroll
    for (int i = 0; i < 4; ++i) { const int cidx = lane + 64 * i, t = 16 * w + (cidx >> 4), v0 = 8 * (cidx & 15);
        const f32x4 x0 = *(const LAS f32x4*)(OT + t * 132 + v0), x1 = *(const LAS f32x4*)(OT + t * 132 + v0 + 4);
        const f32x4 g0 = *(const f32x4*)(F.head_g + h * 128 + v0), g1 = *(const f32x4*)(F.head_g + h * 128 + v0 + 4);
        u32x4 o; o.x = pk2(x0.x * g0.x * sigmf(bflo(og[i].x)), x0.y * g0.y * sigmf(bfhi(og[i].x))); o.y = pk2(x0.z * g0.z * sigmf(bflo(og[i].y)), x0.w * g0.w * sigmf(bfhi(og[i].y)));
        o.z = pk2(x1.x * g1.x * sigmf(bflo(og[i].z)), x1.y * g1.y * sigmf(bfhi(og[i].z))); o.w = pk2(x1.z * g1.z * sigmf(bflo(og[i].w)), x1.w * g1.w * sigmf(bfhi(og[i].w)));
        *(u32x4*)(F.MIXIN() + (size_t)(R0 + t) * 1024 + h * 128 + v0) = o; }
    __syncthreads();
}

constexpr int FS_ = 544;
DI void p6_fourier_item(const Ctx& F, int it) {
    const int xs = it & 7, ss = it >> 3, pair = (ss >> 3) * 8 + xs, a8 = ss & 7, b = pair >> 3, g = pair & 7, cb = 8 * g + a8;
    const int tid = F.tid, lane = F.lane, w = F.wave, fr = lane & 15, fq = lane >> 4;
    LAS unsigned char* XL = F.lds;
    LAS unsigned char* YL = F.lds + 69632;
    LAS float* SR = (LAS float*)F.lds;
    LAS float* SI = SR + 4096;
#pragma unroll
    for (int i = 0; i < 8; ++i) { const int idx = tid + 512 * i, part = idx >> 11, wi = idx & 2047;
        *(LAS u32x4*)(XL + (part * 64 + (wi >> 5)) * FS_ + 16 * (wi & 31)) = *(const u32x4*)(F.FCS() + (size_t)((b * 2 + part) * 64 + cb) * 16384 + wi * 8); }
    __syncthreads();
    {
        const int pr = w & 3, nh = w >> 2;
        bf16x8 a0[4], a1[4];
#pragma unroll
        for (int kk = 0; kk < 4; ++kk) { a0[kk] = *(const bf16x8*)(F.W1() + (16 * pr + fr) * 128 + 32 * kk + 8 * fq); a1[kk] = *(const bf16x8*)(F.W1() + (16 * (pr + 4) + fr) * 128 + 32 * kk + 8 * fq); }
#pragma unroll 1
        for (int hv = 0; hv < 2; ++hv) {
            const unsigned xb = tr_base<FS_, 8>(lds_addr(XL), lane) + 256u * (unsigned)nh + 128u * (unsigned)hv;
            f32x4 yr[4], yi[4];
#pragma unroll
            for (int q4 = 0; q4 < 4; ++q4) { yr[q4] = (f32x4){0.f, 0.f, 0.f, 0.f}; yi[q4] = (f32x4){0.f, 0.f, 0.f, 0.f}; }
#define FT1_KK(kk) { bf16x8 bx[4]; tr2x4<(kk) * 32 * FS_, 4 * FS_>(xb, bx); _Pragma("unroll") for (int q4 = 0; q4 < 4; ++q4) { yr[q4] = MFMA16(a0[kk], bx[q4], yr[q4]); yi[q4] = MFMA16(a1[kk], bx[q4], yi[q4]); } }
            FT1_KK(0) FT1_KK(1) FT1_KK(2) FT1_KK(3)
#undef FT1_KK
#pragma unroll
            for (int q4 = 0; q4 < 4; ++q4) { const int nt = 8 * nh + 4 * hv + q4, n = 16 * nt + fr, n2 = n >> 2, col = n & 3;
#pragma unroll
                for (int r = 0; r < 4; ++r) { const int k1 = 16 * pr + 4 * fq + r; const float ang = (float)((k1 * n2) & 4095) * (1.0f / 4096.0f); const float twx = __builtin_amdgcn_cosf(ang), twy = __builtin_amdgcn_sinf(ang);
                    const float y2r = yr[q4][r] * twx + yi[q4][r] * twy, y2i = yi[q4][r] * twx - yr[q4][r] * twy;
                    *(LAS bf16*)(YL + (0 * 64 + n2) * FS_ + (k1 * 4 + col) * 2) = (bf16)f2bf(y2r); *(LAS bf16*)(YL + (1 * 64 + n2) * FS_ + (k1 * 4 + col) * 2) = (bf16)f2bf(y2i); } }
        }
    }
    __syncthreads();
    {
        const int mt = w & 3, nh = w >> 2;
        bf16x8 ar[4], ai[4];
#pragma unroll
        for (int kk = 0; kk < 4; ++kk) { ar[kk] = *(const bf16x8*)(F.W2() + (16 * mt + fr) * 128 + 32 * kk + 8 * fq); ai[kk] = *(const bf16x8*)(F.W2I() + (16 * mt + fr) * 128 + 32 * kk + 8 * fq); }
        bf16* orow0 = F.MIXIN() + (size_t)(b * 4096) * 1024 + 512 + 64 * g;
#pragma unroll 1
        for (int hv = 0; hv < 2; ++hv) {
            const unsigned yb = tr_base<FS_, 8>(lds_addr(YL), lane) + 256u * (unsigned)nh + 128u * (unsigned)hv;
            f32x4 xr[4], xi[4];
#pragma unroll
            for (int q4 = 0; q4 < 4; ++q4) { xr[q4] = (f32x4){0.f, 0.f, 0.f, 0.f}; xi[q4] = (f32x4){0.f, 0.f, 0.f, 0.f}; }
#define FT2_KK(kk) { bf16x8 by[4]; tr2x4<(kk) * 32 * FS_, 4 * FS_>(yb, by); _Pragma("unroll") for (int q4 = 0; q4 < 4; ++q4) { xr[q4] = MFMA16(ar[kk], by[q4], xr[q4]); if (a8 == 0) xi[q4] = MFMA16(ai[kk], by[q4], xi[q4]); } }
            FT2_KK(0) FT2_KK(1) FT2_KK(2) FT2_KK(3)
#undef FT2_KK
#pragma unroll
            for (int q4 = 0; q4 < 4; ++q4) { const int nt = 8 * nh + 4 * hv + q4, n = 16 * nt + fr, k1 = n >> 2, col = n & 3, j = 4 * a8 + col;
#pragma unroll
                for (int r = 0; r < 4; ++r) { const int k2 = 16 * mt + 4 * fq + r, k = k1 + 64 * k2;
                    if (j == 0) { SR[k] = xr[q4][r]; SI[k] = xi[q4][r]; }
                    else { const bf16 ov = (bf16)f2bf(xr[q4][r] * (1.0f / 512.0f)); orow0[(size_t)k * 1024 + j] = ov; orow0[(size_t)((4096 - k) & 4095) * 1024 + 64 - j] = ov; } } }
        }
    }
    __syncthreads();
    if (a8 == 0) {
        bf16* orow0 = F.MIXIN() + (size_t)(b * 4096) * 1024 + 512 + 64 * g;
#pragma unroll
        for (int i = 0; i < 8; ++i) { const int k = tid + 512 * i, km = (4096 - k) & 4095;
            orow0[(size_t)k * 1024] = (bf16)f2bf((SR[k] + SR[km]) * (0.5f / 512.0f)); orow0[(size_t)k * 1024 + 32] = (bf16)f2bf((SI[k] + SI[km]) * (-0.5f / 512.0f)); }
        __syncthreads();
    }
}

struct OutOrder {
    struct Unit { int pm, pn; }; static constexpr bool GATHER = false;
    int G, c; const bf16* Bt; const bf16* A;
    DI bool next(int i, Unit& u) const { const int L = i * G + c; if (L >= 256) return false; pg8::static_tile(L, 64, 4, u.pm, u.pn); return true; }
    DI const char* a_ptr(const Unit& u) const { return (const char*)(A + (size_t)u.pm * 256 * 1024); }
    DI const char* b_ptr(const Unit& u) const { return (const char*)(Bt + (size_t)u.pn * 256 * 1024); }
};
struct EpiMix {
    static constexpr bool PERM = true;
    bf16* Cm;
    DI void operator()(const f32x4 (&acc)[2][2][4][2], const OutOrder::Unit& u, int wr, int wc, int fr, int fq) const {
        asm volatile("s_nop 15\n\ts_nop 3" ::: "memory");
        const int row0 = u.pm * 256 + wr * 64 + fr, col0 = u.pn * 256 + wc * 32 + 8 * fq;
#pragma unroll
        for (int ai = 0; ai < 2; ++ai)
#pragma unroll
            for (int m = 0; m < 4; ++m) { bf16* rowp = Cm + (size_t)(row0 + ai * 128 + m * 16) * 1024 + col0;
#pragma unroll
                for (int bj = 0; bj < 2; ++bj) { const f32x4 v0 = acc[ai][bj][m][0], v1 = acc[ai][bj][m][1];
                    u32x4 w; w.x = pg8::cvt_pk_bf16(v0[0], v0[1]); w.y = pg8::cvt_pk_bf16(v0[2], v0[3]); w.z = pg8::cvt_pk_bf16(v1[0], v1[1]); w.w = pg8::cvt_pk_bf16(v1[2], v1[3]);
                    *(u32x4*)(rowp + bj * 128) = w; } }
    }
};

DI void p8_rows(const Ctx& F) {
    LAS float* modL = (LAS float*)F.lds;
    LAS bf16* tH = (LAS bf16*)(F.lds + 49152);
    LAS float* PL = (LAS float*)(F.lds + 115200);
    LAS int* lcnt = (LAS int*)(F.lds + 123392);
    LAS int* lbase = (LAS int*)(F.lds + 123648);
    LAS int* selP = (LAS int*)(F.lds + 123904);
    LAS float* selG = (LAS float*)(F.lds + 132096);
    const int lane = F.lane, w = F.wave, tid = F.tid, fr = lane & 15, fq = lane >> 4;
    const int nt = w & 3, kh = w >> 2;
    for (int i = tid; i < 4 * 3072; i += 512) modL[i] = F.MOD()[(i / 3072) * 6144 + 2048 + (i % 3072)];
    f16x8 wbh[16];
#pragma unroll
    for (int kk = 0; kk < 16; ++kk) wbh[kk] = *(const f16x8*)(F.WRH() + (size_t)(16 * nt + fr) * 1024 + 512 * kh + 32 * kk + 8 * fq);
    const float rbias = F.router_bias[lane];
    if (tid < 64) lcnt[tid] = 0;
    __syncthreads();
    int gi = 0;
    f32x4 xa[2][4]; u32x2 ma[2][4];
#define P8_LOAD(g16_) { const int r0_ = 16 * (g16_) + 2 * w; _Pragma("unroll") for (int rr = 0; rr < 2; ++rr) _Pragma("unroll") for (int m = 0; m < 4; ++m) { \
        xa[rr][m] = __builtin_nontemporal_load((const f32x4*)(F.x + (size_t)(r0_ + rr) * 1024 + 256 * m + 4 * lane)); ma[rr][m] = *(const u32x2*)(F.MIXB() + (size_t)(r0_ + rr) * 1024 + 256 * m + 4 * lane); } }
    if (F.bid < MX / 16) P8_LOAD(F.bid)
    for (int g16 = F.bid; g16 < MX / 16; g16 += F.G, ++gi) {
        const int b = (16 * g16) >> 12; const LAS float* md = modL + b * 3072;
        const int row0 = 16 * g16 + 2 * w;
#pragma unroll
        for (int rr = 0; rr < 2; ++rr) {
            const int lr = 2 * w + rr, row = row0 + rr;
            f32x4 v[4]; float s = 0.f;
#pragma unroll
            for (int m = 0; m < 4; ++m) { const f32x4 gt = *(const LAS f32x4*)(md + 256 * m + 4 * lane); const f32x4 mv = (f32x4){bflo(ma[rr][m].x), bfhi(ma[rr][m].x), bflo(ma[rr][m].y), bfhi(ma[rr][m].y)};
                v[m] = xa[rr][m] * ALPHA + gt * mv; s += (v[m].x + v[m].y) + (v[m].z + v[m].w); }
            float mean = wave_sum(s) * (1.0f / 1024.0f), s2 = 0.f;
#pragma unroll
            for (int m = 0; m < 4; ++m) { v[m] = v[m] - mean; s2 += (v[m].x * v[m].x + v[m].y * v[m].y) + (v[m].z * v[m].z + v[m].w * v[m].w); }
            float rstd = 1.0f / sqrtf(wave_sum(s2) * (1.0f / 1024.0f) + LN_EPS);
            s = 0.f;
#pragma unroll
            for (int m = 0; m < 4; ++m) { const int k = 256 * m + 4 * lane; const f32x4 gg = *(const f32x4*)(F.ln1_g + k), bb = *(const f32x4*)(F.ln1_b + k);
                v[m] = v[m] * rstd * gg + bb; u32x2 xo; xo.x = pk2(v[m].x, v[m].y); xo.y = pk2(v[m].z, v[m].w); *(u32x2*)(F.X1() + (size_t)row * 1024 + k) = xo; s += (v[m].x + v[m].y) + (v[m].z + v[m].w); }
            mean = wave_sum(s) * (1.0f / 1024.0f); s2 = 0.f;
#pragma unroll
            for (int m = 0; m < 4; ++m) { v[m] = v[m] - mean; s2 += (v[m].x * v[m].x + v[m].y * v[m].y) + (v[m].z * v[m].z + v[m].w * v[m].w); }
            rstd = 1.0f / sqrtf(wave_sum(s2) * (1.0f / 1024.0f) + LN_EPS);
            bf16* trow = F.T() + (size_t)row * 1024;
#pragma unroll
            for (int m = 0; m < 4; ++m) { const int k = 256 * m + 4 * lane; const f32x4 sh = *(const LAS f32x4*)(md + 1024 + k), sc = *(const LAS f32x4*)(md + 2048 + k);
                const f32x4 t = v[m] * rstd * (sc + 1.0f) + sh;
                u32x2 oh; oh.x = pk2(t.x, t.y); oh.y = pk2(t.z, t.w); *(u32x2*)(trow + k) = oh;
                u32x2 of; of.x = pkh2(t.x, t.y); of.y = pkh2(t.z, t.w); *(LAS u32x2*)(tH + lr * 1032 + k) = of; }
        }
        if (g16 + F.G < MX / 16) P8_LOAD(g16 + F.G)
        __syncthreads();
        {
            f32x4 a0 = (f32x4){0.f, 0.f, 0.f, 0.f}, a2 = a0;
#pragma unroll
            for (int kk = 0; kk < 16; kk += 2) { const f16x8 h0 = *(const LAS f16x8*)(tH + fr * 1032 + 512 * kh + 32 * kk + 8 * fq), h1 = *(const LAS f16x8*)(tH + fr * 1032 + 512 * kh + 32 * (kk + 1) + 8 * fq);
                a0 = __builtin_amdgcn_mfma_f32_16x16x32_f16(h0, wbh[kk], a0, 0, 0, 0); a2 = __builtin_amdgcn_mfma_f32_16x16x32_f16(h1, wbh[kk + 1], a2, 0, 0, 0); }
#pragma unroll
            for (int r = 0; r < 4; ++r) PL[(kh * 16 + 4 * fq + r) * 64 + 16 * nt + fr] = a0[r] + a2[r];
        }
        __syncthreads();
#pragma unroll 1
        for (int rr = 0; rr < 2; ++rr) {
            const int lr = 2 * w + rr; const float logit = PL[lr * 64 + lane] + PL[(16 + lr) * 64 + lane];
            const float score = 1.0f / (1.0f + expf(-logit)); float sb = score + rbias; sb = (sb == sb) ? sb : -1.0f; int rank = 0;
#pragma unroll 8
            for (int j = 0; j < 64; ++j) { const float o = __builtin_bit_cast(float, __builtin_amdgcn_readlane(__builtin_bit_cast(int, sb), j)); rank += (o > sb || (o == sb && j < lane)) ? 1 : 0; }
            const bool sel = rank < TOPK; const float ssum = wave_sum(sel ? score : 0.f);
            if (sel) { const int lidx = __hip_atomic_fetch_add(lcnt + lane, 1, __ATOMIC_RELAXED, __HIP_MEMORY_SCOPE_WORKGROUP);
                selP[(gi * 16 + lr) * 8 + rank] = lane | (lidx << 8); selG[(gi * 16 + lr) * 8 + rank] = 2.5f * score / ssum; }
        }
        __syncthreads();
    }
    if (tid < 64) lbase[tid] = (int)__hip_atomic_fetch_add(F.ctl() + (F.dry ? CW_CNT2 : CW_CNT) + 16 * tid, (unsigned)lcnt[tid], __ATOMIC_RELAXED, __HIP_MEMORY_SCOPE_AGENT);
    __syncthreads();
    for (int i = tid; i < gi * 128; i += 512) { const int lr = i >> 3, k = i & 7, row = 16 * (F.bid + (lr >> 4) * F.G) + (lr & 15);
        const int p = selP[i], e = p & 255, pos = lbase[e] + (p >> 8);
        F.ROWTAB()[(size_t)e * 16384 + pos] = row; F.EIDX()[row * 8 + k] = e; F.EPOS()[row * 8 + k] = pos; F.EGATE()[row * 8 + k] = selG[i]; }
#undef P8_LOAD
}

DI void moe_tiles_to_lds(const Ctx& F) {
    LAS int* tb = (LAS int*)(F.lds + LDS_TB); LAS int* cn = tb + 66; LAS int* sxb = tb + 132;
    if (F.tid < 64) { const int c = (int)__hip_atomic_load(F.ctl() + CW_CNT + 16 * F.tid, __ATOMIC_RELAXED, __HIP_MEMORY_SCOPE_AGENT); const int nt = (c + 255) >> 8;
        float fi = scan_add((float)nt, F.lane); const int incl = (int)(fi + 0.5f);
        tb[F.tid] = incl - nt; cn[F.tid] = c; if (F.tid == 63) { tb[64] = incl; tb[65] = incl + 64; cn[64] = MX; } }
    __syncthreads();
    if (F.tid == 0) { const int T = tb[65]; int prev = 0; sxb[0] = 0;
        for (int x = 0; x < 8; ++x) { int sh = ((x + 1) * T + 4) / 8 - tb[8 * x + 8]; sh = sh < prev ? prev : sh; sh = sh > 64 ? 64 : sh; if (x == 7) sh = 64; sxb[x + 1] = sh; prev = sh; } }
    __syncthreads();
}
DI int moe_find(const LAS int* tb, int tt) { int e = 0;
#pragma unroll
    for (int s = 64; s >= 1; s >>= 1) if (e + s <= 64 && tb[e + s] <= tt) e += s;
    return e; }
DI bool moe_unit(const LAS int* tb, int G, int c, int i, int upt  , int& tt, int& pn, int& e) {
    const LAS int* sxb = tb + 132; const int x = c & 7, idx = (c >> 3) + i * (G >> 3);
    const int own = upt * (tb[8 * x + 8] - tb[8 * x]), sh = upt * (sxb[x + 1] - sxb[x]);
    if (idx >= own + sh) return false;
    if (idx < own) { tt = tb[8 * x] + idx / upt; pn = idx % upt; e = 0;
#pragma unroll
        for (int q = 1; q < 8; ++q) e += (tb[8 * x + q] <= tt) ? 1 : 0;
        e += 8 * x; }
    else { const int su = idx - own; tt = tb[64] + sxb[x] + su / upt; pn = su % upt; e = 64; }
    tt = __builtin_amdgcn_readfirstlane(tt); pn = __builtin_amdgcn_readfirstlane(pn); e = __builtin_amdgcn_readfirstlane(e);
    return true;
}
struct Moe1Order {
    struct Unit { int tt, pn, e, slot; }; static constexpr bool GATHER = true;
    int G, c; const bf16* WguT; const LAS int* tb; const LAS int* rowL;
    DI bool next(int i, Unit& u) const { if (i >= MOE1_SLOTS) return false; u.slot = i; return moe_unit(tb, G, c, i, 2, u.tt, u.pn, u.e); }
    DI void a_off(const Unit& u, const int (&R)[2], const int (&C)[2], unsigned (&off)[2][2]) const {
#pragma unroll
        for (int h = 0; h < 2; ++h)
#pragma unroll
            for (int i = 0; i < 2; ++i) off[h][i] = (unsigned)(rowL[u.slot * 256 + h * 128 + R[i]] * 1024 + C[i]) * 2u; }
    DI const char* b_ptr(const Unit& u) const { return (const char*)(WguT + ((size_t)u.e * 512 + u.pn * 256) * 1024); }
};
struct EpiGu {
    static constexpr bool PERM = true;
    bf16* HB;
    DI void operator()(const f32x4 (&acc)[2][2][4][2], const Moe1Order::Unit& u, int wr, int wc, int fr, int fq) const {
        const int row0 = u.tt * 256 + wr * 64 + fr, col0 = u.pn * 128 + wc * 32 + 8 * fq;
#pragma unroll
        for (int ai = 0; ai < 2; ++ai)
#pragma unroll
            for (int m = 0; m < 4; ++m) { const f32x4 g0 = acc[ai][0][m][0], g1 = acc[ai][0][m][1], u0 = acc[ai][1][m][0], u1 = acc[ai][1][m][1];
                u32x4 w; w.x = pg8::cvt_pk_bf16(siluf(g0[0]) * u0[0], siluf(g0[1]) * u0[1]); w.y = pg8::cvt_pk_bf16(siluf(g0[2]) * u0[2], siluf(g0[3]) * u0[3]);
                w.z = pg8::cvt_pk_bf16(siluf(g1[0]) * u1[0], siluf(g1[1]) * u1[1]); w.w = pg8::cvt_pk_bf16(siluf(g1[2]) * u1[2], siluf(g1[3]) * u1[3]);
                *(u32x4*)(HB + (size_t)(row0 + ai * 128 + m * 16) * 256 + col0) = w; }
    }
};
struct Moe2Order {
    struct Unit { int tt, pn, e; }; static constexpr bool GATHER = false;
    int G, c; const bf16* WdT; const LAS int* tb; const bf16* A;
    DI bool next(int i, Unit& u) const { return moe_unit(tb, G, c, i, 4, u.tt, u.pn, u.e); }
    DI const char* a_ptr(const Unit& u) const { return (const char*)(A + (size_t)u.tt * 256 * 256); }
    DI const char* b_ptr(const Unit& u) const { return (const char*)(WdT + ((size_t)u.e * 1024 + u.pn * 256) * 256); }
};
constexpr float YB_SCALE = 32.0f;
struct EpiDn {
    static constexpr bool PERM = true;
    unsigned char* YB;
    DI void operator()(const f32x4 (&acc)[2][2][4][2], const Moe2Order::Unit& u, int wr, int wc, int fr, int fq) const {
        const int row0 = u.tt * 256 + wr * 64 + fr, col0 = u.pn * 256 + wc * 32 + 8 * fq;
#pragma unroll
        for (int ai = 0; ai < 2; ++ai)
#pragma unroll
            for (int m = 0; m < 4; ++m) { unsigned char* rowp = YB + (size_t)(row0 + ai * 128 + m * 16) * 1024 + col0;
#pragma unroll
                for (int bj = 0; bj < 2; ++bj) { f32x4 v0 = acc[ai][bj][m][0] * YB_SCALE, v1 = acc[ai][bj][m][1] * YB_SCALE;
#pragma unroll
                    for (int q = 0; q < 4; ++q) { v0[q] = __builtin_amdgcn_fmed3f(v0[q], -448.f, 448.f); v1[q] = __builtin_amdgcn_fmed3f(v1[q], -448.f, 448.f); }
                    int p0 = __builtin_amdgcn_cvt_pk_fp8_f32(v0[0], v0[1], 0, false); p0 = __builtin_amdgcn_cvt_pk_fp8_f32(v0[2], v0[3], p0, true);
                    int p1 = __builtin_amdgcn_cvt_pk_fp8_f32(v1[0], v1[1], 0, false); p1 = __builtin_amdgcn_cvt_pk_fp8_f32(v1[2], v1[3], p1, true);
                    u32x2 w; w.x = (unsigned)p0; w.y = (unsigned)p1; *(u32x2*)(rowp + bj * 128) = w; } }
    }
};
DI void p9_fill_rows(const Ctx& F) {
    const LAS int* tb = (const LAS int*)(F.lds + LDS_TB); const LAS int* cn = tb + 66; LAS int* rowL = (LAS int*)(F.lds + LDS_ROWL);
    for (int i = 0; i < MOE1_SLOTS; ++i) { int tt, pn, e; if (!moe_unit(tb, F.G, F.bid, i, 2, tt, pn, e)) break; const int rt = tt - tb[e];
        if (F.tid < 256) { const int r = 256 * rt + F.tid; rowL[i * 256 + F.tid] = e < 64 ? (r < cn[e] ? F.ROWTAB()[(size_t)e * 16384 + r] : 0) : r; } }
    __syncthreads();
}
DI void p11_acc(float (&acc)[16], float g, const u32x4 q) {
    const unsigned wv[4] = {q.x, q.y, q.z, q.w};
#pragma unroll
    for (int i = 0; i < 4; ++i) { const f32x2 lo = __builtin_amdgcn_cvt_pk_f32_fp8((int)wv[i], false), hi = __builtin_amdgcn_cvt_pk_f32_fp8((int)wv[i], true);
        acc[4 * i] += g * lo.x; acc[4 * i + 1] += g * lo.y; acc[4 * i + 2] += g * hi.x; acc[4 * i + 3] += g * hi.y; } }
DI void p11_combine(const Ctx& F) {
    LAS float* modL = (LAS float*)F.lds;
    const LAS int* tb = (const LAS int*)(F.lds + LDS_TB);
    for (int i = F.tid; i < 4 * 1024; i += 512) modL[i] = F.MOD()[(i >> 10) * 6144 + 5120 + (i & 1023)];
    __syncthreads();
    const int lane = F.lane, gw = F.bid * 8 + F.wave, NGW = F.G * 8;
    const unsigned char* YB8 = (const unsigned char*)F.YB();
    u32x4 q[9], qn[9]; u32x4 xv[2], xvn[2]; float gg[9], ggn[9]; int ei[8], pi[8]; float gi[8];
#define P11_IDX(r) { const int* ep_ = F.EIDX() + (r) * 8; const int* pp_ = F.EPOS() + (r) * 8; const float* gp_ = F.EGATE() + (r) * 8; \
        _Pragma("unroll") for (int k = 0; k < 8; ++k) { ei[k] = ep_[k]; pi[k] = pp_[k]; gi[k] = gp_[k]; } }
#define P11_ISSUE(r, Q, X, G) { _Pragma("unroll") for (int k = 0; k < 8; ++k) { Q[k] = *(const u32x4*)(YB8 + (size_t)(tb[ei[k]] * 256 + pi[k]) * 1024 + 16 * lane); G[k] = gi[k] * (1.0f / YB_SCALE); } \
        Q[8] = *(const u32x4*)(YB8 + (size_t)(tb[64] * 256 + (r)) * 1024 + 16 * lane); G[8] = 1.0f / YB_SCALE; \
        _Pragma("unroll") for (int i = 0; i < 2; ++i) X[i] = *(const u32x4*)(F.X1() + (size_t)(r) * 1024 + 16 * lane + 8 * i); }
    int row = gw;
    if (row < MX) { P11_IDX(row) P11_ISSUE(row, q, xv, gg) if (row + NGW < MX) P11_IDX(row + NGW) }
    while (row < MX) {
        const int nrow = row + NGW;
        if (nrow < MX) { P11_ISSUE(nrow, qn, xvn, ggn) if (nrow + NGW < MX) P11_IDX(nrow + NGW) }
        float* orow = F.out + (size_t)row * 1024; const LAS float* md = modL + (row >> 12) * 1024;
        float acc[16];
#pragma unroll
        for (int j = 0; j < 16; ++j) acc[j] = 0.f;
#pragma unroll
        for (int k = 0; k < 9; ++k) p11_acc(acc, gg[k], q[k]);
        float v[16]; float s = 0.f;
#pragma unroll
        for (int i = 0; i < 4; ++i) { const f32x4 g4 = *(const LAS f32x4*)(md + 16 * lane + 4 * i); const unsigned xw0 = (i & 1) ? xv[i >> 1].z : xv[i >> 1].x, xw1 = (i & 1) ? xv[i >> 1].w : xv[i >> 1].y;
            v[4 * i] = ALPHA * bflo(xw0) + g4.x * acc[4 * i]; v[4 * i + 1] = ALPHA * bfhi(xw0) + g4.y * acc[4 * i + 1]; v[4 * i + 2] = ALPHA * bflo(xw1) + g4.z * acc[4 * i + 2]; v[4 * i + 3] = ALPHA * bfhi(xw1) + g4.w * acc[4 * i + 3];
            s += (v[4 * i] + v[4 * i + 1]) + (v[4 * i + 2] + v[4 * i + 3]); }
        const float mean = wave_sum(s) * (1.0f / 1024.0f); float s2 = 0.f;
#pragma unroll
        for (int j = 0; j < 16; ++j) { v[j] -= mean; s2 += v[j] * v[j]; }
        const float rstd = 1.0f / sqrtf(wave_sum(s2) * (1.0f / 1024.0f) + LN_EPS);
#pragma unroll
        for (int i = 0; i < 4; ++i) { const int c0 = 16 * lane + 4 * i; const f32x4 ga = *(const f32x4*)(F.ln2_g + c0), ba = *(const f32x4*)(F.ln2_b + c0);
            f32x4 o; o.x = v[4 * i] * rstd * ga.x + ba.x; o.y = v[4 * i + 1] * rstd * ga.y + ba.y; o.z = v[4 * i + 2] * rstd * ga.z + ba.z; o.w = v[4 * i + 3] * rstd * ga.w + ba.w;
            *(f32x4*)(orow + c0) = o; }
#pragma unroll
        for (int k = 0; k < 9; ++k) { q[k] = qn[k]; gg[k] = ggn[k]; }
#pragma unroll
        for (int i = 0; i < 2; ++i) xv[i] = xvn[i];
        row = nrow;
    }
#undef P11_IDX
#undef P11_ISSUE
}

constexpr int NPHASE = 12;
__global__ void __launch_bounds__(512, 2) mk_fwd(Args args) {
    extern __shared__ __attribute__((aligned(16))) unsigned char lds_raw[];
    Ctx F;
    F.lds = (LAS unsigned char*)lds_raw;
    F.tid = threadIdx.x; F.lane = F.tid & 63; F.wave = __builtin_amdgcn_readfirstlane(F.tid >> 6); F.G = gridDim.x; F.bid = blockIdx.x; F.dry = args.pad;
    F.x = args.in[0]; F.c = args.in[1]; F.ctx = args.in[2]; F.c_ctx = args.in[3]; F.w_ada = args.in[4]; F.b_ada = args.in[5]; F.w_in = args.in[6]; F.conv_w = args.in[7]; F.conv_b = args.in[8];
    F.gate_b = args.in[9]; F.head_g = args.in[10]; F.w_out = args.in[11]; F.ln1_g = args.in[12]; F.ln1_b = args.in[13]; F.w_router = args.in[14]; F.router_bias = args.in[15];
    F.w_egu = args.in[16]; F.w_ed = args.in[17]; F.w_sgu = args.in[18]; F.w_sd = args.in[19]; F.ln2_g = args.in[20]; F.ln2_b = args.in[21];
    F.out = args.out; F.ws = args.ws;
    volatile LAS unsigned* MISC = (volatile LAS unsigned*)(F.lds + LDS_MISC);
    for (int u = F.tid; u < (LDS_BYTES - LDS_MISC) / 4; u += 512) MISC[u] = 0u;
    __syncthreads();
    XcdBarrier bar; bar.bar = F.ctl() + CW_BAR; bar.x = 0; bar.st = nullptr;
    if (MK_N_LAUNCHES == 1) bar = xcd_barrier_post(F.ctl() + CW_BAR, MISC + 8);
    const int lo = args.ph_lo, hi = args.ph_hi;
#define IN(k) (lo <= (k) && (k) < hi)
#define SEAM(k) do { if (IN(k) && IN((k) + 1)) xcd_barrier(bar); } while (0)
#ifndef PROBE_REP
#define PROBE_REP -1
#endif

    if (IN(0)) { p0_prologue(F); }
    if (IN(1)) { p1_lnmod(F); } SEAM(1);
    if (IN(2)) { ProjOrder S{F.G, F.bid, F.WINT(), F.XN()}; EpiProj E{F.PROJ(), F.FCS()}; pg8::gemm_phase<EpiProj, ProjOrder, GEMM_SP2, GEMM_ALIGN>(F.lds, (const char*)F.XN(), 1024, S, E);
        if (F.G == 256 && MK_N_LAUNCHES == 1 && F.bid >= P2_BUSY)
            p0_transposes(F, (LAS float*)(F.lds + F.wave * 17408), T_EARLY + (F.bid - P2_BUSY) * 8 + F.wave, (256 - P2_BUSY) * 8, T_ALL); } SEAM(2);
    if (IN(3)) { p3_conv(F); } SEAM(3);
    if (IN(4)) { for (int it = F.bid; it < NITEM4; it += F.G) p4_item(F, it); } SEAM(4);
    if (IN(5)) { p5_scan(F); } SEAM(5);
    if (IN(6)) { if (F.dry != 2) for (int it = F.bid; it < 512; it += F.G) p6_mlstm_item(F, it);
                 if (F.dry != 1) for (int it = F.bid; it < 256; it += F.G) p6_fourier_item(F, it); } SEAM(6);
    if (IN(7)) { OutOrder S{F.G, F.bid, F.WOUTT(), F.MIXIN()}; EpiMix E{F.MIXB()}; pg8::gemm_phase<EpiMix, OutOrder, GEMM_SP2, GEMM_ALIGN>(F.lds, (const char*)F.MIXIN(), 1024, S, E); } SEAM(7);
    if (IN(8)) { p8_rows(F); } SEAM(8);
    if (IN(9)) { moe_tiles_to_lds(F); p9_fill_rows(F);
        Moe1Order S{F.G, F.bid, F.WGUT(), (const LAS int*)(F.lds + LDS_TB), (const LAS int*)(F.lds + LDS_ROWL)}; EpiGu E{F.HB()};
        pg8::gemm_phase<EpiGu, Moe1Order, GEMM_SP2, GEMM_ALIGN>(F.lds, (const char*)F.T(), 1024, S, E); } SEAM(9);
    if (IN(10)) { moe_tiles_to_lds(F); Moe2Order S{F.G, F.bid, F.WDT(), (const LAS int*)(F.lds + LDS_TB), F.HB()}; EpiDn E{(unsigned char*)F.YB()};
        pg8::gemm_phase<EpiDn, Moe2Order, GEMM_SP2, GEMM_ALIGN>(F.lds, (const char*)F.HB(), 256, S, E); } SEAM(10);
    if (IN(11)) { moe_tiles_to_lds(F); p11_combine(F); }
#undef IN
#undef SEAM
}

extern "C" void kernel_launch(void* const* d_in, const int* in_sizes, int n_in, void* d_out, int out_size, void* d_ws, size_t ws_size, hipStream_t stream) {
    static int grid = 0;
    if (grid == 0) {
        if (n_in != 22 || out_size != MX * DM || ws_size < WS_END) { fprintf(stderr, "kernel_launch: unexpected problem (n_in %d, out %d, ws %zu)\n", n_in, out_size, ws_size); grid = -1; return; }
        int dev = 0, cus = 0, per_cu = 0;
        if (hipGetDevice(&dev) != hipSuccess || hipDeviceGetAttribute(&cus, hipDeviceAttributeMultiprocessorCount, dev) != hipSuccess) { grid = -1; return; }
        if (hipFuncSetAttribute((const void*)mk_fwd, hipFuncAttributeMaxDynamicSharedMemorySize, LDS_BYTES) != hipSuccess) { fprintf(stderr, "kernel_launch: hipFuncSetAttribute failed\n"); grid = -1; return; }
        if (hipOccupancyMaxActiveBlocksPerMultiprocessor(&per_cu, (const void*)mk_fwd, 512, LDS_BYTES) != hipSuccess || per_cu < 1) { fprintf(stderr, "kernel_launch: occupancy query says %d\n", per_cu); per_cu = 1; }
        (void)hipGetLastError();
        grid = cus;
        if (grid > 256) grid = 256;
        grid &= ~7;
    }
    if (grid < 0) return;
    (void)in_sizes;
    if (hipMemsetAsync((char*)d_ws + WS_CTL, 0, CTL_ZERO_BYTES, stream) != hipSuccess) return;
    Args a{};
    for (int i = 0; i < 22; ++i) a.in[i] = (const float*)d_in[i];
    a.out = (float*)d_out; a.ws = (unsigned char*)d_ws;
    for (int li = 0; li < MK_N_LAUNCHES; ++li) {
        a.ph_lo = (MK_N_LAUNCHES == 1) ? 0 : li; a.ph_hi = (MK_N_LAUNCHES == 1) ? NPHASE : li + 1; a.li = li; a.pad = 0;
        if (MK_N_LAUNCHES > 1 && li == PROBE_REP) { a.pad = 1; hipLaunchKernelGGL(mk_fwd, dim3(grid), dim3(512), LDS_BYTES, stream, a); a.pad = 0; }
        if (MK_N_LAUNCHES > 1 && li == PROBE_REP - 200) { a.pad = 2; hipLaunchKernelGGL(mk_fwd, dim3(grid), dim3(512), LDS_BYTES, stream, a); a.pad = 0; }
        if (MK_N_LAUNCHES > 1 && li == PROBE_REP - 100) { a.pad = 1; for (int q = 0; q < 3; ++q) hipLaunchKernelGGL(mk_fwd, dim3(grid), dim3(512), LDS_BYTES, stream, a); a.pad = 0; }
        hipLaunchKernelGGL(mk_fwd, dim3(grid), dim3(512), LDS_BYTES, stream, a);
    }
}
```
